# Optimizing an MI355X kernel written in HIP

```python
import math
import jax, jax.numpy as jnp
from jax import lax
import numpy as np

D_MODEL = 1024
BATCH = 8
SEQ = 4096
DEPTH = 4

CHUNK = 64
Q_BLOCK = 128
ROPE_THETA = 10000.0
NORM_EPS = 1e-6

N_EVEN = (DEPTH + 1) // 2
N_ODD = DEPTH // 2

A_HEADS = D_MODEL // 128
A_HEAD_DIM = 64
A_LEFT_CHUNKS = 8
A_BAND = (A_LEFT_CHUNKS + 1) * CHUNK
A_MAX_REL = 256
A_WIDTH = A_HEADS * A_HEAD_DIM

B_HEADS = D_MODEL // 128
B_NOPE_DIM = 64
B_ROPE_DIM = 32
B_V_DIM = 64
B_Q_LORA = D_MODEL // 4
B_KV_LORA = D_MODEL // 8
B_WIDTH = B_HEADS * B_V_DIM

EVEN_IN = 3 * A_WIDTH + B_Q_LORA + B_KV_LORA + B_ROPE_DIM
EVEN_MIX = A_WIDTH + B_WIDTH

C_HEAD_DIM = 64
C_HEADS = D_MODEL // (2 * C_HEAD_DIM)
C_WIDTH = C_HEADS * 2 * C_HEAD_DIM

FF_DENSE = 2816
N_EXPERTS = 8
TOP_K = 2
FF_EXPERT = 3584

kernel_name = "hybrid_chunk_causal_relpos_mla_diffattn_moe"


def rms_norm(x, g, eps=NORM_EPS):
    x32 = x.astype(jnp.float32)
    y = x32 * lax.rsqrt(jnp.mean(x32 * x32, axis=-1, keepdims=True) + eps)
    return (y * g.astype(jnp.float32)).astype(x.dtype)


def rope_tables(positions, dim):
    inv_freq = 1.0 / jnp.power(ROPE_THETA, jnp.arange(0, dim, 2, dtype=jnp.float32) / dim)
    ang = positions.astype(jnp.float32)[..., None] * inv_freq
    return jnp.cos(ang), jnp.sin(ang)


def apply_rope(x, cos, sin):
    x1, x2 = jnp.split(x, 2, axis=-1)
    c = cos[:, None].astype(x.dtype)
    s = sin[:, None].astype(x.dtype)
    return jnp.concatenate([x1 * c - x2 * s, x1 * s + x2 * c], axis=-1)


def to_heads(t, n_heads):
    b, s, _ = t.shape
    return t.reshape(b, s, n_heads, -1).transpose(0, 2, 1, 3)


def from_heads(t):
    b, h, s, d = t.shape
    return t.transpose(0, 2, 1, 3).reshape(b, s, h * d)


def chunk_causal_mask(start, seq):
    q_chunk = (start + jnp.arange(Q_BLOCK)) // CHUNK
    k_chunk = jnp.arange(seq) // CHUNK
    return k_chunk[None, :] <= q_chunk[:, None]


def masked_softmax(s, mask):
    s = jnp.where(mask, s.astype(jnp.float32), -jnp.inf)
    return jax.nn.softmax(s, axis=-1)


def sweep_query_blocks(block_fn, qs):
    b, h, s, _ = qs[0].shape
    nb = s // Q_BLOCK
    blocked = tuple(q.reshape(b, h, nb, Q_BLOCK, q.shape[-1]).transpose(2, 0, 1, 3, 4) for q in qs)
    starts = jnp.arange(nb, dtype=jnp.int32) * Q_BLOCK
    out = lax.map(lambda args: block_fn(args[0], *args[1:]), (starts,) + blocked)
    return out.transpose(1, 2, 0, 3, 4).reshape(b, h, s, out.shape[-1])


def chunked_relpos_attention(q, k, v, rel_bias):
    b, h, s, dh = q.shape
    nc = s // CHUNK
    qc = q.reshape(b, h, nc, CHUNK, dh)
    pad = ((0, 0), (0, 0), (A_LEFT_CHUNKS * CHUNK, 0), (0, 0))
    kp = jnp.pad(k, pad).reshape(b, h, nc + A_LEFT_CHUNKS, CHUNK, dh)
    vp = jnp.pad(v, pad).reshape(b, h, nc + A_LEFT_CHUNKS, CHUNK, dh)
    kb = jnp.concatenate([kp[:, :, w:w + nc] for w in range(A_LEFT_CHUNKS + 1)], axis=3)
    vb = jnp.concatenate([vp[:, :, w:w + nc] for w in range(A_LEFT_CHUNKS + 1)], axis=3)
    rel = A_LEFT_CHUNKS * CHUNK + jnp.arange(CHUNK)[:, None] - jnp.arange(A_BAND)[None, :]
    rel = jnp.clip(rel, -A_MAX_REL, A_MAX_REL) + A_MAX_REL
    bias = rel_bias[:, rel].astype(jnp.float32)
    key_chunk = jnp.arange(nc)[:, None] - A_LEFT_CHUNKS + (jnp.arange(A_BAND) // CHUNK)[None, :]
    valid = key_chunk >= 0
    sc = jnp.einsum('bhnqd,bhnkd->bhnqk', qc, kb).astype(jnp.float32) * (dh ** -0.5) + bias[:, None]
    p = masked_softmax(sc, valid[:, None, :])
    o = jnp.einsum('bhnqk,bhnkd->bhnqd', p.astype(v.dtype), vb)
    return o.reshape(b, h, s, dh)


def mla_attention(c_q, c_kv, k_rope_raw, cos, sin, q_norm_g, w_uq, kv_norm_g, w_ukv):
    b, s, _ = c_q.shape
    q = to_heads(rms_norm(c_q, q_norm_g) @ w_uq, B_HEADS)
    q_nope, q_rope = q[..., :B_NOPE_DIM], q[..., B_NOPE_DIM:]
    kv = to_heads(rms_norm(c_kv, kv_norm_g) @ w_ukv, B_HEADS)
    k_nope, v = kv[..., :B_NOPE_DIM], kv[..., B_NOPE_DIM:]
    q_rope = apply_rope(q_rope, cos, sin)
    k_rope = apply_rope(k_rope_raw[:, None], cos, sin)
    q_full = jnp.concatenate([q_nope, q_rope], axis=-1)
    k_full = jnp.concatenate([k_nope, jnp.broadcast_to(k_rope, (b, B_HEADS, s, B_ROPE_DIM))], axis=-1)
    scale = (B_NOPE_DIM + B_ROPE_DIM) ** -0.5

    def block(start, qb):
        sc = jnp.einsum('bhqd,bhkd->bhqk', qb, k_full) * scale
        p = masked_softmax(sc, chunk_causal_mask(start, s))
        return jnp.einsum('bhqk,bhkd->bhqd', p.astype(v.dtype), v)

    return sweep_query_blocks(block, (q_full,))


def diff_attention(q, k, v, cos, sin, lam_q1, lam_k1, lam_q2, lam_k2, subln_g, lambda_init):
    s = q.shape[2]
    q1, q2 = jnp.split(q, 2, axis=-1)
    k1, k2 = jnp.split(k, 2, axis=-1)
    q1, q2 = apply_rope(q1, cos, sin), apply_rope(q2, cos, sin)
    k1, k2 = apply_rope(k1, cos, sin), apply_rope(k2, cos, sin)
    f32 = jnp.float32
    lam = (jnp.exp(jnp.sum(lam_q1.astype(f32) * lam_k1.astype(f32)))
           - jnp.exp(jnp.sum(lam_q2.astype(f32) * lam_k2.astype(f32))) + lambda_init)
    scale = C_HEAD_DIM ** -0.5

    def block(start, q1b, q2b):
        mask = chunk_causal_mask(start, s)
        p1 = masked_softmax(jnp.einsum('bhqd,bhkd->bhqk', q1b, k1) * scale, mask)
        p2 = masked_softmax(jnp.einsum('bhqd,bhkd->bhqk', q2b, k2) * scale, mask)
        a = p1 - lam * p2
        return jnp.einsum('bhqk,bhkd->bhqd', a.astype(v.dtype), v)

    o = sweep_query_blocks(block, (q1, q2))
    return rms_norm(o, subln_g) * (1.0 - lambda_init)


def swiglu(x, w_gu, w_down):
    gate, up = jnp.split(x @ w_gu, 2, axis=-1)
    return (jax.nn.silu(gate) * up) @ w_down


def moe_swiglu(x, w_router, w_gu, w_down):
    b, s, d = x.shape
    t = x.reshape(b * s, d)
    logits = (t @ w_router).astype(jnp.float32)
    top_v, top_i = lax.top_k(logits, TOP_K)
    gates = jax.nn.softmax(top_v, axis=-1)
    combine = jnp.sum(jax.nn.one_hot(top_i, N_EXPERTS, dtype=jnp.float32) * gates[..., None], axis=1)
    y = jnp.zeros_like(t)
    for e in range(N_EXPERTS):
        y = y + combine[:, e:e + 1].astype(t.dtype) * swiglu(t, w_gu[e], w_down[e])
    return y.reshape(b, s, d)


def diff_lambda_init(layer):
    return 0.8 - 0.6 * math.exp(-0.3 * layer)


def setup_inputs(seed: int = 0) -> dict:
    key = jax.random.key(seed)
    ks = iter(jax.random.split(key, 32))
    f32 = jnp.float32

    def w(shape, fan_in):
        return jax.random.normal(next(ks), shape, f32) * (fan_in ** -0.5)

    def gain(shape):
        return 1.0 + 0.02 * jax.random.normal(next(ks), shape, f32)

    x = jax.random.normal(next(ks), (BATCH, SEQ, D_MODEL), f32)
    offset = jax.random.randint(next(ks), (BATCH, 1), 0, 16, dtype=jnp.int32) * CHUNK
    positions = (offset + jnp.arange(SEQ, dtype=jnp.int32)[None, :]).astype(jnp.int32)
    return {
        "x": x,
        "positions": positions,
        "mix_norm_g": gain((DEPTH, D_MODEL)),
        "ffn_norm_g": gain((DEPTH, D_MODEL)),
        "w_in_even": w((N_EVEN, D_MODEL, EVEN_IN), D_MODEL),
        "rel_bias_a": 0.5 * jax.random.normal(next(ks), (N_EVEN, A_HEADS, 2 * A_MAX_REL + 1), f32),
        "q_norm_b": gain((N_EVEN, B_Q_LORA)),
        "w_uq_b": w((N_EVEN, B_Q_LORA, B_HEADS * (B_NOPE_DIM + B_ROPE_DIM)), B_Q_LORA),
        "kv_norm_b": gain((N_EVEN, B_KV_LORA)),
        "w_ukv_b": w((N_EVEN, B_KV_LORA, B_HEADS * (B_NOPE_DIM + B_V_DIM)), B_KV_LORA),
        "w_out_even": w((N_EVEN, EVEN_MIX, D_MODEL), EVEN_MIX),
        "w_in_odd": w((N_ODD, D_MODEL, 3 * C_WIDTH), D_MODEL),
        "lambda_q1": 0.1 * jax.random.normal(next(ks), (N_ODD, C_HEAD_DIM), f32),
        "lambda_k1": 0.1 * jax.random.normal(next(ks), (N_ODD, C_HEAD_DIM), f32),
        "lambda_q2": 0.1 * jax.random.normal(next(ks), (N_ODD, C_HEAD_DIM), f32),
        "lambda_k2": 0.1 * jax.random.normal(next(ks), (N_ODD, C_HEAD_DIM), f32),
        "subln_g": gain((N_ODD, 2 * C_HEAD_DIM)),
        "w_out_odd": w((N_ODD, C_WIDTH, D_MODEL), C_WIDTH),
        "w_gu_dense": w((N_EVEN, D_MODEL, 2 * FF_DENSE), D_MODEL),
        "w_down_dense": w((N_EVEN, FF_DENSE, D_MODEL), FF_DENSE),
        "w_router": w((N_ODD, D_MODEL, N_EXPERTS), D_MODEL),
        "w_gu_moe": w((N_ODD, N_EXPERTS, D_MODEL, 2 * FF_EXPERT), D_MODEL),
        "w_down_moe": w((N_ODD, N_EXPERTS, FF_EXPERT, D_MODEL), FF_EXPERT),
        "final_norm_g": gain((D_MODEL,)),
    }


def reference(x, positions, mix_norm_g, ffn_norm_g, w_in_even, rel_bias_a, q_norm_b, w_uq_b,
              kv_norm_b, w_ukv_b, w_out_even, w_in_odd, lambda_q1, lambda_k1, lambda_q2,
              lambda_k2, subln_g, w_out_odd, w_gu_dense, w_down_dense, w_router, w_gu_moe,
              w_down_moe, final_norm_g):
    cos_b, sin_b = rope_tables(positions, B_ROPE_DIM)
    cos_c, sin_c = rope_tables(positions, C_HEAD_DIM)
    h = x
    for layer in range(DEPTH):
        i = layer // 2
        hn = rms_norm(h, mix_norm_g[layer])
        if layer % 2 == 0:
            proj = hn @ w_in_even[i]
            o1 = A_WIDTH
            o2 = o1 + A_WIDTH
            o3 = o2 + A_WIDTH
            o4 = o3 + B_Q_LORA
            o5 = o4 + B_KV_LORA
            qa = to_heads(proj[..., :o1], A_HEADS)
            ka = to_heads(proj[..., o1:o2], A_HEADS)
            va = to_heads(proj[..., o2:o3], A_HEADS)
            out_a = chunked_relpos_attention(qa, ka, va, rel_bias_a[i])
            out_b = mla_attention(proj[..., o3:o4], proj[..., o4:o5], proj[..., o5:], cos_b, sin_b,
                                  q_norm_b[i], w_uq_b[i], kv_norm_b[i], w_ukv_b[i])
            mix = jnp.concatenate([from_heads(out_a), from_heads(out_b)], axis=-1)
            h = h + mix @ w_out_even[i]
            h = h + swiglu(rms_norm(h, ffn_norm_g[layer]), w_gu_dense[i], w_down_dense[i])
        else:
            qkv = hn @ w_in_odd[i]
            qc = to_heads(qkv[..., :C_WIDTH], C_HEADS)
            kc = to_heads(qkv[..., C_WIDTH:2 * C_WIDTH], C_HEADS)
            vc = to_heads(qkv[..., 2 * C_WIDTH:], C_HEADS)
            out_c = diff_attention(qc, kc, vc, cos_c, sin_c, lambda_q1[i], lambda_k1[i],
                                   lambda_q2[i], lambda_k2[i], subln_g[i], diff_lambda_init(layer))
            h = h + from_heads(out_c) @ w_out_odd[i]
            h = h + moe_swiglu(rms_norm(h, ffn_norm_g[layer]), w_router[i], w_gu_moe[i], w_down_moe[i])
    return rms_norm(h, final_norm_g)
```

```cpp
#include <hip/hip_runtime.h>
#include <stdint.h>
#include <stdio.h>
#include <cmath>
#define MOE_CONV_OVL 0
#ifndef ONE_LAUNCH
#define ONE_LAUNCH 1
#endif

constexpr int NB = 8, SEQ = 4096, T = NB * SEQ, D = 1024;
constexpr float EPS = 1e-6f;
constexpr float LOG2E = 1.4426950408889634f;
constexpr int FFD = 2816, FFE = 3584, NEXP = 8;
constexpr int NSLOT = 2 * T + NEXP * 256;
constexpr int EIN = 1952;
constexpr int NCHUNK_R = 256, RCH = 128;

typedef unsigned short bf16;
typedef unsigned v4u __attribute__((ext_vector_type(4)));
typedef unsigned v2u __attribute__((ext_vector_type(2)));
typedef float f32x4 __attribute__((ext_vector_type(4)));

constexpr size_t MiB = 1u << 20;
constexpr size_t WS_CTL = 0;
constexpr size_t WS_META = 1 * MiB;
constexpr size_t WS_SSQ = 14 * MiB;
constexpr size_t WS_SSQQ = 16 * MiB;
constexpr size_t WS_SSQKV = 16 * MiB + 512 * 1024;
constexpr size_t WS_TOPE = 17 * MiB;
constexpr size_t WS_TOPG = WS_TOPE + 256 * 1024;
constexpr size_t WS_LRANK = WS_TOPG + 256 * 1024;
constexpr size_t WS_SLOT = WS_LRANK + 256 * 1024;
constexpr size_t WS_TOKI = 18 * MiB;
constexpr size_t WS_GATE = WS_TOKI + 512 * 1024;
constexpr size_t WS_H = 20 * MiB;
constexpr size_t WS_HB = 148 * MiB;
constexpr size_t WS_W = 212 * MiB;
constexpr size_t WS_AR = 612 * MiB;
constexpr size_t WS_TMP = 1340 * MiB;
constexpr size_t WS_END = 1724 * MiB;
constexpr size_t AR_QA = 0, AR_KA = 32 * MiB, AR_VAT = 64 * MiB, AR_CQ = 96 * MiB, AR_CKV = 112 * MiB  , AR_QB = 128 * MiB, AR_KB = 176 * MiB, AR_VBT = 224 * MiB, AR_MIX = 256 * MiB;
constexpr size_t AR_ACT = 0;
constexpr size_t AR_HB8 = 192 * MiB;
constexpr size_t AR_QC = 0, AR_KC = 64 * MiB, AR_VCT = 128 * MiB;
constexpr size_t AR_XG = 0, AR_HN = 68 * MiB  , AR_ACTM = 136 * MiB, AR_Y = 598 * MiB;

typedef float f32x2_t __attribute__((ext_vector_type(2))); typedef __bf16 bf16x2_t __attribute__((ext_vector_type(2)));
__device__ __forceinline__ unsigned pk2(float lo, float hi) { const f32x2_t v = {lo, hi}; const bf16x2_t b = __builtin_convertvector(v, bf16x2_t); return __builtin_bit_cast(unsigned, b); }
__device__ __forceinline__ unsigned f2bf(float f) { return pk2(f, 0.f) & 0xffffu; }
__device__ __forceinline__ float bf2f(unsigned b) { return __builtin_bit_cast(float, b << 16); }
__device__ __forceinline__ float wave_sum(float v) {
#pragma unroll
    for (int o = 1; o < 64; o <<= 1) v += __shfl_xor(v, o);
    return v;
}
__device__ __forceinline__ float wave_max(float v) {
#pragma unroll
    for (int o = 1; o < 64; o <<= 1) v = fmaxf(v, __shfl_xor(v, o));
    return v;
}
__host__ __device__ __forceinline__ int permk(int s) { return (s & ~12) | ((s & 4) << 1) | ((s & 8) >> 1); }

struct P {
    const float* x; const int* pos; const float* mix_g; const float* ffn_g; const float* w_in_e; const float* relb; const float* qn_g; const float* w_uq;
    const float* kvn_g; const float* w_ukv; const float* w_out_e; const float* w_in_o; const float* lq1; const float* lk1; const float* lq2; const float* lk2;
    const float* subln; const float* w_out_o; const float* w_gu_d; const float* w_dn_d; const float* w_rt; const float* w_gu_m; const float* w_dn_m; const float* fin_g;
    float* out; unsigned char* ws;
    int layer, last;
};

#ifndef MOE_FP8
#define MOE_FP8 1
#endif
#ifndef H_BF16
#define H_BF16 1
#endif
#ifndef FFN8_GU
#define FFN8_GU 2
#endif
#ifndef FFN8_DN
#define FFN8_DN 2
#endif
#ifndef FFN_FP8
#define FFN_FP8 0
#endif
__device__ __forceinline__ unsigned pk4_fp8x(float a, float b, float c, float d) {
    int w = __builtin_amdgcn_cvt_pk_fp8_f32(__builtin_amdgcn_fmed3f(a, -448.f, 448.f), __builtin_amdgcn_fmed3f(b, -448.f, 448.f), 0, false);
    w = __builtin_amdgcn_cvt_pk_fp8_f32(__builtin_amdgcn_fmed3f(c, -448.f, 448.f), __builtin_amdgcn_fmed3f(d, -448.f, 448.f), w, true); return (unsigned)w; }
__device__ __forceinline__ void ph_prologue(const P& p, int bid, int nblk) {
    const int tid = threadIdx.x, nth = blockDim.x, lane = tid & 63, wave = tid >> 6, nw = nth >> 6;
    bf16* HB = (bf16*)(p.ws + WS_HB); float* SSQ = (float*)(p.ws + WS_SSQ);
    const int stride = nblk * nw; int row = bid * nw + wave;
    f32x4 v[4];
    if (row < T) { const f32x4* xr = (const f32x4*)(p.x + (size_t)row * D) + lane;
#pragma unroll
        for (int j = 0; j < 4; ++j) v[j] = xr[64 * j]; }
    for (; row < T; row += stride) {
        f32x4 vn[4];
        { const int rn = row + stride < T ? row + stride : row; const f32x4* xr = (const f32x4*)(p.x + (size_t)rn * D) + lane;
#pragma unroll
          for (int j = 0; j < 4; ++j) vn[j] = xr[64 * j]; }
        float s = 0.f;
#pragma unroll
        for (int j = 0; j < 4; ++j) s += v[j].x * v[j].x + v[j].y * v[j].y + v[j].z * v[j].z + v[j].w * v[j].w;
        s = wave_sum(s);
        v2u* o = (v2u*)(HB + (size_t)row * D) + lane;
#pragma unroll
        for (int j = 0; j < 4; ++j) { v2u w; w.x = pk2(v[j].x, v[j].y); w.y = pk2(v[j].z, v[j].w); o[64 * j] = w; }
        if (lane < 16) SSQ[row * 16 + lane] = lane == 0 ? s : 0.f;
#pragma unroll
        for (int j = 0; j < 4; ++j) v[j] = vn[j];
    }
}

template <class IP> __device__ __forceinline__ void ph_route(const P& p, int layer, int bid, int nblk, IP se  ) {
    const int tid = threadIdx.x, nth = blockDim.x, lane = tid & 63, wave = tid >> 6, nw = nth >> 6;
    const int i2 = layer >> 1;
    const float* H = (const float*)(p.ws + WS_H); bf16* HB = (bf16*)(p.ws + WS_HB); (void)H;
    bf16* HNo = H_BF16 ? (bf16*)(p.ws + WS_AR + AR_HN) : HB;
    const float* g = p.ffn_g + layer * D; const float* wr = p.w_rt + (size_t)i2 * D * 8;
    int* TOPE = (int*)(p.ws + WS_TOPE); float* TOPG = (float*)(p.ws + WS_TOPG); int* LRANK = (int*)(p.ws + WS_LRANK); int* CNT = (int*)(p.ws + WS_META + 4096);
    float wg[16][8];
#pragma unroll
    for (int j = 0; j < 4; ++j)
#pragma unroll
        for (int q = 0; q < 4; ++q) { const int k = lane * 4 + 256 * j + q; const float gk = g[k];
            const f32x4 w0 = *(const f32x4*)(wr + (size_t)k * 8), w1 = *(const f32x4*)(wr + (size_t)k * 8 + 4);
            wg[4 * j + q][0] = w0.x * gk; wg[4 * j + q][1] = w0.y * gk; wg[4 * j + q][2] = w0.z * gk; wg[4 * j + q][3] = w0.w * gk;
            wg[4 * j + q][4] = w1.x * gk; wg[4 * j + q][5] = w1.y * gk; wg[4 * j + q][6] = w1.z * gk; wg[4 * j + q][7] = w1.w * gk; }
    const bool b5 = lane & 32, b4 = lane & 16, b3 = lane & 8;
    for (int ch = bid; ch < NCHUNK_R; ch += nblk) {
#if H_BF16
#define RT_LOAD(V, tk) do { const v2u* hr_ = (const v2u*)(HB + (size_t)(tk) * D) + lane; _Pragma("unroll") for (int j = 0; j < 4; ++j) { const v2u t_ = hr_[64 * j]; \
        V[j].x = bf2f(t_.x & 0xffffu); V[j].y = bf2f(t_.x >> 16); V[j].z = bf2f(t_.y & 0xffffu); V[j].w = bf2f(t_.y >> 16); } } while (0)
#else
#define RT_LOAD(V, tk) do { const f32x4* hr_ = (const f32x4*)(H + (size_t)(tk) * D) + lane; _Pragma("unroll") for (int j = 0; j < 4; ++j) V[j] = hr_[64 * j]; } while (0)
#endif
        f32x4 v[4];
        RT_LOAD(v, ch * RCH + wave);
        for (int i = wave; i < RCH; i += nw) {
            const int tok = ch * RCH + i;
            f32x4 vn[4];
            { const int tn = (i + nw < RCH) ? tok + nw : tok; RT_LOAD(vn, tn); }
            float s = 0.f;
#pragma unroll
            for (int j = 0; j < 4; ++j) s += v[j].x * v[j].x + v[j].y * v[j].y + v[j].z * v[j].z + v[j].w * v[j].w;
            s = wave_sum(s);
            const float rstd = 1.0f / sqrtf(s * (1.f / D) + EPS);
            float lg[8];
#pragma unroll
            for (int e = 0; e < 8; ++e) lg[e] = 0.f;
            v2u* o = (v2u*)(HNo + (size_t)tok * D) + lane;
#pragma unroll
            for (int j = 0; j < 4; ++j) {
                const float hn[4] = {v[j].x * rstd, v[j].y * rstd, v[j].z * rstd, v[j].w * rstd};
                v2u w; w.x = pk2(hn[0], hn[1]); w.y = pk2(hn[2], hn[3]); o[64 * j] = w;
#pragma unroll
                for (int q = 0; q < 4; ++q)
#pragma unroll
                    for (int e = 0; e < 8; ++e) lg[e] += hn[q] * wg[4 * j + q][e];
            }
            float a4[4], a2[2];
#pragma unroll
            for (int e = 0; e < 4; ++e) { const float keep = b5 ? lg[e + 4] : lg[e], send = b5 ? lg[e] : lg[e + 4]; a4[e] = keep + __shfl_xor(send, 32); }
#pragma unroll
            for (int e = 0; e < 2; ++e) { const float keep = b4 ? a4[e + 2] : a4[e], send = b4 ? a4[e] : a4[e + 2]; a2[e] = keep + __shfl_xor(send, 16); }
            float c1; { const float keep = b3 ? a2[1] : a2[0], send = b3 ? a2[0] : a2[1]; c1 = keep + __shfl_xor(send, 8); }
            c1 += __shfl_xor(c1, 4); c1 += __shfl_xor(c1, 2); c1 += __shfl_xor(c1, 1);
            float lt[8];
#pragma unroll
            for (int e = 0; e < 8; ++e) lt[e] = __uint_as_float(__builtin_amdgcn_readlane(__float_as_uint(c1), 32 * (e >> 2) + 16 * ((e >> 1) & 1) + 8 * (e & 1)));
            int e1 = 0; float v1 = lt[0];
#pragma unroll
            for (int e = 1; e < 8; ++e) if (lt[e] > v1) { v1 = lt[e]; e1 = e; }
            int e2 = -1; float v2 = -INFINITY;
#pragma unroll
            for (int e = 0; e < 8; ++e) if (e != e1 && lt[e] > v2) { v2 = lt[e]; e2 = e; }
            const float g1 = 1.f / (1.f + expf(v2 - v1));
            if (lane == 0) { se[2 * i] = e1; se[2 * i + 1] = e2; TOPE[tok * 2] = e1; TOPE[tok * 2 + 1] = e2; TOPG[tok * 2] = g1; TOPG[tok * 2 + 1] = 1.f - g1; }
#pragma unroll
            for (int j = 0; j < 4; ++j) v[j] = vn[j];
        }
        __syncthreads();
        IP wcnt = se + 256;
        int myr = 0, mye = 0;
        if (wave < 4) { mye = se[64 * wave + lane];
#pragma unroll
            for (int e = 0; e < 8; ++e) { const unsigned long long m = __ballot(mye == e); if (mye == e) myr = __popcll(m & ((1ull << lane) - 1ull)); if (lane == 0) wcnt[wave * 8 + e] = __popcll(m); } }
        __syncthreads();
        if (wave < 4) { for (int w2 = 0; w2 < wave; ++w2) myr += wcnt[w2 * 8 + mye]; LRANK[ch * 256 + 64 * wave + lane] = myr; }
        if (tid < 8) CNT[ch * 8 + tid] = wcnt[tid] + wcnt[8 + tid] + wcnt[16 + tid] + wcnt[24 + tid];
        __syncthreads();
    }
}

template <class IP> __device__ __forceinline__ void ph_gather(const P& p, int bid, int nblk, IP base  ) {
    const int tid = threadIdx.x, nth = blockDim.x, lane = tid & 63, wave = tid >> 6, nw = nth >> 6;
    const int* CNT = (const int*)(p.ws + WS_META + 4096); int* META = (int*)(p.ws + WS_META);
    IP seg = base + 2048; IP tot = base + 2048 + 16;
    for (int i = tid; i < 2048; i += nth) base[i] = CNT[i];
    __syncthreads();
    if (wave < 8) {
        const int e = wave; int c[4], t = 0;
#pragma unroll
        for (int i = 0; i < 4; ++i) { c[i] = base[(4 * lane + i) * 8 + e]; t += c[i]; }
        int inc = t;
#pragma unroll
        for (int d = 1; d < 64; d <<= 1) { const int u = __shfl_up(inc, d); if (lane >= d) inc += u; }
        int run = inc - t;
#pragma unroll
        for (int i = 0; i < 4; ++i) { base[(4 * lane + i) * 8 + e] = run; run += c[i]; }
        if (lane == 63) tot[e] = inc;
    }
    __syncthreads();
    if (tid == 0) { int s = 0; for (int e = 0; e < 8; ++e) { seg[e] = s; s += (tot[e] + 255) & ~255; } seg[8] = s; }
    __syncthreads();
    if (bid == 0 && tid < 9) META[tid] = seg[tid];
    if (bid == 0 && tid < 8) META[16 + tid] = tot[tid];
    const int* TOPE = (const int*)(p.ws + WS_TOPE); const float* TOPG = (const float*)(p.ws + WS_TOPG); const int* LRANK = (const int*)(p.ws + WS_LRANK);
    int* SLOT = (int*)(p.ws + WS_SLOT); int* TOKI = (int*)(p.ws + WS_TOKI); float* GATE = (float*)(p.ws + WS_GATE);
    const bf16* HB = H_BF16 ? (const bf16*)(p.ws + WS_AR + AR_HN) : (const bf16*)(p.ws + WS_HB); bf16* XG = (bf16*)(p.ws + WS_AR + AR_XG);
    IP lslot = base + 2048 + 32;
    for (int ch = bid; ch < NCHUNK_R; ch += nblk) {
        if (tid < 256) { const int ent = ch * 256 + tid; const int e = TOPE[ent]; const int slot = seg[e] + base[ch * 8 + e] + LRANK[ent];
            SLOT[ent] = slot; TOKI[slot] = ent; GATE[slot] = TOPG[ent]; lslot[tid] = slot; }
        __syncthreads();
#pragma unroll 4
        for (int j = wave; j < 256; j += nw) {
            const int tok = (ch * 256 + j) >> 1; const int slot = lslot[j];
#if MOE_FP8
            const v4u* src = (const v4u*)(HB + (size_t)tok * D) + 2 * lane; const v4u a = src[0], b = src[1];
            v4u o;
            o.x = pk4_fp8x(bf2f(a.x & 0xffffu), bf2f(a.x >> 16), bf2f(a.y & 0xffffu), bf2f(a.y >> 16)); o.y = pk4_fp8x(bf2f(a.z & 0xffffu), bf2f(a.z >> 16), bf2f(a.w & 0xffffu), bf2f(a.w >> 16));
            o.z = pk4_fp8x(bf2f(b.x & 0xffffu), bf2f(b.x >> 16), bf2f(b.y & 0xffffu), bf2f(b.y >> 16)); o.w = pk4_fp8x(bf2f(b.z & 0xffffu), bf2f(b.z >> 16), bf2f(b.w & 0xffffu), bf2f(b.w >> 16));
            *((v4u*)((unsigned char*)XG + (size_t)slot * D) + lane) = o;
#else
            const v4u* src = (const v4u*)(HB + (size_t)tok * D) + lane; v4u* dst = (v4u*)(XG + (size_t)slot * D) + lane;
            dst[0] = src[0]; dst[64] = src[64];
#endif
        }
        __syncthreads();
    }
    for (int e = 0; e < 8; ++e) {
        const int s0 = seg[e] + tot[e], npad = seg[e + 1] - s0;
        for (int q = bid * nw + wave; q < npad; q += nblk * nw) {
            const int slot = s0 + q;
            if (lane == 0) { TOKI[slot] = -1; GATE[slot] = 0.f; }
            const v4u z = {0u, 0u, 0u, 0u};
#if MOE_FP8
            *((v4u*)((unsigned char*)XG + (size_t)slot * D) + lane) = z;
#else
            v4u* dst = (v4u*)(XG + (size_t)slot * D) + lane; dst[0] = z; dst[64] = z;
#endif
        }
    }
}

__device__ __forceinline__ void ph_combine(const P& p, int last, int bid, int nblk) {
    const int tid = threadIdx.x, nth = blockDim.x, lane = tid & 63, wave = tid >> 6, nw = nth >> 6;
    float* H = (float*)(p.ws + WS_H); bf16* HB = (bf16*)(p.ws + WS_HB); float* SSQ = (float*)(p.ws + WS_SSQ);
    const bf16* Y = (const bf16*)(p.ws + WS_AR + AR_Y);
    const int stride = nblk * nw; int row = bid * nw + wave;
    f32x4 v[4]; v2u ya[4], yb[4];
#if H_BF16
#define CMB_LOAD(r, V, A, B) do { const v2u* hr_ = (const v2u*)(HB + (size_t)(r) * D) + lane; const v2u* y0_ = (const v2u*)(Y + (size_t)(r) * D) + lane; const v2u* y1_ = (const v2u*)(Y + (size_t)(T + (r)) * D) + lane; \
        _Pragma("unroll") for (int j = 0; j < 4; ++j) { const v2u t_ = hr_[64 * j]; V[j].x = bf2f(t_.x & 0xffffu); V[j].y = bf2f(t_.x >> 16); V[j].z = bf2f(t_.y & 0xffffu); V[j].w = bf2f(t_.y >> 16); A[j] = y0_[64 * j]; B[j] = y1_[64 * j]; } } while (0)
#else
#define CMB_LOAD(r, V, A, B) do { const f32x4* hr_ = (const f32x4*)(H + (size_t)(r) * D) + lane; const v2u* y0_ = (const v2u*)(Y + (size_t)(r) * D) + lane; const v2u* y1_ = (const v2u*)(Y + (size_t)(T + (r)) * D) + lane; \
        _Pragma("unroll") for (int j = 0; j < 4; ++j) { V[j] = hr_[64 * j]; A[j] = y0_[64 * j]; B[j] = y1_[64 * j]; } } while (0)
#endif
    if (row < T) CMB_LOAD(row, v, ya, yb);
    for (; row < T; row += stride) {
        f32x4 vn[4]; v2u yan[4], ybn[4];
        { const int rn = row + stride < T ? row + stride : row; CMB_LOAD(rn, vn, yan, ybn); }
        float s = 0.f;
#pragma unroll
        for (int j = 0; j < 4; ++j) {
            const v2u a = ya[j], b = yb[j];
            v[j].x += bf2f(a.x & 0xffffu) + bf2f(b.x & 0xffffu); v[j].y += bf2f(a.x >> 16) + bf2f(b.x >> 16);
            v[j].z += bf2f(a.y & 0xffffu) + bf2f(b.y & 0xffffu); v[j].w += bf2f(a.y >> 16) + bf2f(b.y >> 16);
            s += v[j].x * v[j].x + v[j].y * v[j].y + v[j].z * v[j].z + v[j].w * v[j].w;
        }
        s = wave_sum(s);
        if (last) {
            const float rstd = 1.0f / sqrtf(s * (1.f / D) + EPS);
            f32x4* orow = (f32x4*)(p.out + (size_t)row * D) + lane;
#pragma unroll
            for (int j = 0; j < 4; ++j) { const f32x4 gv = *((const f32x4*)p.fin_g + lane + 64 * j); f32x4 o; o.x = v[j].x * rstd * gv.x; o.y = v[j].y * rstd * gv.y; o.z = v[j].z * rstd * gv.z; o.w = v[j].w * rstd * gv.w; orow[64 * j] = o; }
        } else {
            f32x4* hr = (f32x4*)(H + (size_t)row * D) + lane; v2u* o = (v2u*)(HB + (size_t)row * D) + lane;
#pragma unroll
            for (int j = 0; j < 4; ++j) { if (!H_BF16) hr[64 * j] = v[j]; v2u w; w.x = pk2(v[j].x, v[j].y); w.y = pk2(v[j].z, v[j].w); o[64 * j] = w; }
            if (lane < 16) SSQ[row * 16 + lane] = lane == 0 ? s : 0.f;
        }
#pragma unroll
        for (int j = 0; j < 4; ++j) { v[j] = vn[j]; ya[j] = yan[j]; yb[j] = ybn[j]; }
    }
#undef CMB_LOAD
}


#define GAS __attribute__((address_space(1)))
#define LAS __attribute__((address_space(3)))
typedef short bf16x8 __attribute__((ext_vector_type(8)));
typedef float f32x16 __attribute__((ext_vector_type(16)));
typedef float f32x2 __attribute__((ext_vector_type(2)));
typedef GAS unsigned gu32;
#define RLX_AGENT __ATOMIC_RELAXED, __HIP_MEMORY_SCOPE_AGENT
#define LDS_WAIT() asm volatile("s_waitcnt lgkmcnt(0)" ::: "memory")

constexpr int NWAVES = 8;
constexpr int LDS_BYTES = 147456;
constexpr int LDSCTL_OFF = LDS_BYTES - 512;
constexpr int CW_BAR = 4096;

constexpr size_t WO_IN_E = 0, WO_UQ = 8 * MiB, WO_UKV = 9 * MiB, WO_OUT_E = 10 * MiB, WO_IN_O = 14 * MiB, WO_OUT_O = 26 * MiB, WO_GU_D = 30 * MiB, WO_DN_D = 52 * MiB, WO_GU_M = 63 * MiB, WO_DN_M = 287 * MiB;
enum { WK_IN_E = 0, WK_UQ, WK_UKV, WK_OUT_E, WK_IN_O, WK_OUT_O, WK_GU_D, WK_DN_D, WK_GU_M, WK_DN_M, WK_N };
struct WKind { int K, NS, ND, KD, ninst; size_t off; };
__device__ __host__ constexpr WKind wkind(int k) {
    return k == WK_IN_E ? WKind{1024, 1952, 2048, 1024, 2, WO_IN_E} : k == WK_UQ ? WKind{256, 768, 768, 256, 2, WO_UQ} : k == WK_UKV ? WKind{128, 1024, 1024, 256, 2, WO_UKV}
         : k == WK_OUT_E ? WKind{1024, 1024, 1024, 1024, 2, WO_OUT_E} : k == WK_IN_O ? WKind{1024, 3072, 3072, 1024, 2, WO_IN_O} : k == WK_OUT_O ? WKind{1024, 1024, 1024, 1024, 2, WO_OUT_O}
         : k == WK_GU_D ? WKind{1024, 5632, 5632, 1024, 2, WO_GU_D} : k == WK_DN_D ? WKind{2816, 1024, 1024, 2816, 2, WO_DN_D} : k == WK_GU_M ? WKind{1024, 7168, 7168, 1024, 16, WO_GU_M}
         : WKind{3584, 1024, 1024, 3584, 16, WO_DN_M};
}
__device__ __host__ constexpr long witems(int k) { return (long)wkind(k).ninst * (wkind(k).KD / 64) * (wkind(k).ND / 256); }
__device__ __forceinline__ int srccol(int kind, int n) {
    switch (kind) {
    case WK_IN_E: return n < EIN ? n : -1;
    case WK_UQ: { if (n < 512) return (n >> 6) * 96 + (n & 63); const int t = n - 512, half = t >> 7, tt = t & 127; return (tt >> 4) * 96 + 64 + 16 * half + (tt & 15); }
    case WK_IN_O: { if (n >= 2048) return n; const int pn = n >> 8, t = n & 255, half = t >> 7, tt = t & 127; return (pn < 4 ? 0 : 1024) + 64 * (4 * (pn & 3) + (tt >> 5)) + 32 * half + (tt & 31); }
    case WK_GU_D: { const int pn = n >> 8, t = n & 255; return t < 128 ? 128 * pn + t : FFD + 128 * pn + t - 128; }
    case WK_GU_M: { const int pn = n >> 8, t = n & 255; return t < 128 ? 128 * pn + t : FFE + 128 * pn + t - 128; }
    default: return n;
    }
}
#ifndef MOE_FP8
#define MOE_FP8 1
#endif
struct WItem { const float* W; const float* gain; unsigned char* dst; int K, NS, KD, kind, k0, n0; float wscale; int fp8; };
__device__ __forceinline__ WItem wconv_decode(const P& p, long it) {
    long r = it; int kind = 0;
#pragma unroll
    for (int k = 0; k < WK_N - 1; ++k) { if (kind == k && r >= witems(k)) { r -= witems(k); kind = k + 1; } }
    int K, NS, ND, KD; size_t off; const float* src; const float* gain = nullptr;
    switch (kind) {
#define WCASE(kk) case kk: K = wkind(kk).K; NS = wkind(kk).NS; ND = wkind(kk).ND; KD = wkind(kk).KD; off = wkind(kk).off; break;
        WCASE(WK_IN_E) WCASE(WK_UQ) WCASE(WK_UKV) WCASE(WK_OUT_E) WCASE(WK_IN_O) WCASE(WK_OUT_O) WCASE(WK_GU_D) WCASE(WK_DN_D) WCASE(WK_GU_M) default: WCASE(WK_DN_M)
#undef WCASE
    }
    const int per = (KD / 64) * (ND / 256); const int inst = (int)(r / per), ii = (int)(r % per), nb = ii / (KD / 64), kb = ii % (KD / 64);
    switch (kind) {
    case WK_IN_E: src = p.w_in_e; gain = p.mix_g + (2 * inst) * D; break;
    case WK_UQ: src = p.w_uq; gain = p.qn_g + inst * 256; break;
    case WK_UKV: src = p.w_ukv; gain = p.kvn_g + inst * 128; break;
    case WK_OUT_E: src = p.w_out_e; break;
    case WK_IN_O: src = p.w_in_o; gain = p.mix_g + (2 * inst + 1) * D; break;
    case WK_OUT_O: src = p.w_out_o; break;
    case WK_GU_D: src = p.w_gu_d; gain = p.ffn_g + (2 * inst) * D; break;
    case WK_DN_D: src = p.w_dn_d; break;
    case WK_GU_M: src = p.w_gu_m; gain = p.ffn_g + (2 * (inst >> 3) + 1) * D; break;
    default: src = p.w_dn_m; break;
    }
    WItem w; w.W = src + (size_t)inst * K * NS; w.gain = gain; w.K = K; w.NS = NS; w.KD = KD; w.kind = kind; w.k0 = 64 * kb; w.n0 = 256 * nb;
    const bool f8 = (MOE_FP8 && (kind == WK_GU_M || kind == WK_DN_M)) || (kind == WK_GU_D && ((FFN8_GU >> inst) & 1)) || (kind == WK_DN_D && ((FFN8_DN >> inst) & 1));
    w.fp8 = f8 ? 1 : 0; w.wscale = f8 ? ((kind == WK_GU_M || kind == WK_GU_D) ? 64.f : 128.f) : 1.f;
    w.dst = p.ws + WS_W + off + (size_t)inst * ND * KD * ((kind == WK_GU_M || kind == WK_DN_M) && MOE_FP8 ? 1 : 2);
    return w;
}
constexpr int WC_LD = 257;
__device__ __forceinline__ void wconv_load(const WItem& w, int wave, int lane, f32x4 (&v)[8], float& g, float& ls) {
    const int sc = srccol(w.kind, w.n0 + 4 * lane), scc = sc >= 0 ? sc : 0, kb = w.k0 + 8 * wave;
    ls = sc >= 0 ? w.wscale : 0.f;
    const float* gp = w.gain ? w.gain : w.W;
    { int k = kb + (lane & 7); k = k < w.K ? k : 0; g = gp[k]; }
#pragma unroll
    for (int i = 0; i < 8; ++i) { int k = kb + i; k = k < w.K ? k : 0; v[i] = *(const f32x4*)(w.W + (size_t)k * w.NS + scc); }
}
__device__ __forceinline__ void wconv_lds_write(const WItem& w, int wave, int lane, const f32x4 (&v)[8], float g, float ls, LAS float* tl) {
    const int kb = w.k0 + 8 * wave;
#pragma unroll
    for (int i = 0; i < 8; ++i) {
        const float gi = __int_as_float(__builtin_amdgcn_readlane(__float_as_int(g), i));
        const float s = (kb + i < w.K) ? (w.gain ? ls * gi : ls) : 0.f;
        LAS float* d = tl + (8 * wave + i) * WC_LD + 4 * lane; d[0] = v[i].x * s; d[1] = v[i].y * s; d[2] = v[i].z * s; d[3] = v[i].w * s; }
}
__device__ __forceinline__ void wconv_lds_read_store(const WItem& w, int wave, int lane, LAS float* tl) {
    const int tid = wave * 64 + lane;
    if (w.fp8) {
#pragma unroll
        for (int q = 0; q < 2; ++q) { const int task = tid + 512 * q, n = task >> 2, c = task & 3; const LAS float* s = tl + (16 * c) * WC_LD + n;
            unsigned ww[4];
#pragma unroll
            for (int j = 0; j < 4; ++j) { const LAS float* t = s + (4 * j) * WC_LD; int x = __builtin_amdgcn_cvt_pk_fp8_f32(t[0], t[WC_LD], 0, false); x = __builtin_amdgcn_cvt_pk_fp8_f32(t[2 * WC_LD], t[3 * WC_LD], x, true); ww[j] = (unsigned)x; }
            *(v4u*)(w.dst + (size_t)(w.n0 + n) * w.KD + w.k0 + 16 * c) = (v4u){ww[0], ww[1], ww[2], ww[3]}; }
    } else {
#pragma unroll
        for (int q = 0; q < 4; ++q) { const int task = tid + 512 * q, n = task >> 3, c = task & 7; const LAS float* s = tl + (8 * c) * WC_LD + n;
            v4u o; o.x = pk2(s[0], s[WC_LD]); o.y = pk2(s[2 * WC_LD], s[3 * WC_LD]); o.z = pk2(s[4 * WC_LD], s[5 * WC_LD]); o.w = pk2(s[6 * WC_LD], s[7 * WC_LD]);
            *(v4u*)((bf16*)w.dst + (size_t)(w.n0 + n) * w.KD + w.k0 + 8 * c) = o; }
    }
}
__device__ __forceinline__ void wconv_store(const WItem& w, int wave, int lane, const f32x4 (&v)[8], float g, float ls, LAS float* tl) {
    wconv_lds_write(w, wave, lane, v, g, ls, tl);
    __syncthreads();
    wconv_lds_read_store(w, wave, lane, tl);
    __syncthreads();
}
#ifndef MOE_CONV_OVL
#define MOE_CONV_OVL 1
#endif
constexpr int MOE_CONV_PER_WG = 21, MOE_CONV_BLOCKS = 5376, WCONV_LDS_OFF = 69632;
static_assert(MOE_CONV_BLOCKS == 8 * (16 * 28 + 56 * 4) && MOE_CONV_BLOCKS == 256 * MOE_CONV_PER_WG, "expert weight blocks per odd layer");
__device__ __forceinline__ long witems_before(int kind) { long t = 0;
#pragma unroll
    for (int k = 0; k < WK_N; ++k) if (k < kind) t += witems(k);
    return t; }
__device__ __forceinline__ WItem moe_conv_item(const P& p, int pr, int q) {
    const long it = q < 3584 ? witems_before(WK_GU_M) + (long)pr * 3584 + q : witems_before(WK_DN_M) + (long)pr * 1792 + (q - 3584);
    return wconv_decode(p, it);
}
__device__ __forceinline__ void ph_wconv(const P& p, LAS unsigned char* lds, int bid, int nblk) {
    const int tid = threadIdx.x, lane = tid & 63, wave = __builtin_amdgcn_readfirstlane(tid >> 6);
    LAS float* tl = (LAS float*)lds;
    long total = 0;
#pragma unroll
    for (int k = 0; k < WK_N; ++k) total += witems(k);
    if (nblk == 256 && MOE_FP8 && MOE_CONV_OVL) total = witems_before(WK_GU_M);
    if (bid >= total) return;
    WItem cur = wconv_decode(p, bid); f32x4 v[8]; float g, ls; wconv_load(cur, wave, lane, v, g, ls);
    for (long it = bid; it < total; it += nblk) {
        const bool more = it + nblk < total;
        WItem nxt = cur; f32x4 vn[8]; float gn = 0.f, lsn = 0.f;
        if (more) { nxt = wconv_decode(p, it + nblk); wconv_load(nxt, wave, lane, vn, gn, lsn); }
        wconv_store(cur, wave, lane, v, g, ls, tl);
        if (more) { cur = nxt; g = gn; ls = lsn;
#pragma unroll
            for (int i = 0; i < 8; ++i) v[i] = vn[i]; }
    }
}

namespace pg8 {
typedef int v4i __attribute__((ext_vector_type(4))); typedef int v8i __attribute__((ext_vector_type(8)));
constexpr int BM = 256, BK = 64, HALF = 128, HTB = HALF * BK * 2, NXCD = 8, WGM = 8;
__host__ __device__ __forceinline__ int lds_byte(int r, int c) { const int st = (r >> 4) * 2 + (c >> 5), rr = r & 15, cc = c & 31, ob = rr * 64 + cc * 2; return st * 1024 + (ob ^ (((ob >> 9) & 1) << 5)); }
__host__ __device__ __forceinline__ void stage_rc(int b, int& R, int& C) { const int st = b / 1024, sb = b % 1024, swz = sb ^ (((sb >> 9) & 1) << 5); R = (st >> 1) * 16 + swz / 64; C = (st & 1) * 32 + (swz % 64) / 2; }
__host__ __device__ __forceinline__ int perm32(int rho) { const int n = rho >> 4, i = rho & 15; return 8 * (i >> 2) + 4 * n + (i & 3); }

struct Unit { int pm, pn, e; };
struct Gemm { unsigned char* ws; unsigned aoff, boff; int N, K; };

struct StaticOrder {
    int nM, nN, nwg, G, c; const int* seg;
    __device__ __forceinline__ void init(int M, int N, int G_, int c_, const int* seg_) { asm volatile("" : "+s"(G_), "+s"(c_));
        seg = seg_; nM = (seg_ ? __builtin_amdgcn_readfirstlane(seg_[8]) : M) / BM; nN = N / BM; nwg = nM * nN; G = G_; c = c_; }
    __device__ __forceinline__ bool next(int i, Unit& u) const {
        const long L = (long)i * G + c; if (L >= nwg) return false;
        int wgid = (int)L; { const int q = nwg / NXCD, r = nwg % NXCD, xcd = wgid % NXCD, off = wgid / NXCD; wgid = (xcd < r ? xcd * (q + 1) : r * (q + 1) + (xcd - r) * q) + off; }
        const int nig = WGM * nN, gid = wgid / nig, fm = gid * WGM, gsz = (nM - fm) < WGM ? (nM - fm) : WGM;
        u.pm = fm + ((wgid % nig) % gsz); u.pn = (wgid % nig) / gsz; u.e = 0;
        if (seg) { int e = 0;
#pragma unroll
            for (int q = 1; q < 8; ++q) e += (seg[q] <= u.pm * BM) ? 1 : 0;
            u.e = __builtin_amdgcn_readfirstlane(e); }
        return true;
    }
};

template <class Epi, class Sched, bool FP8 = false>
__device__ __forceinline__ void gemm_phase(LAS unsigned char* lds, const Gemm g, const Sched& S, const Epi& E) {
    int tid = threadIdx.x; asm volatile("" : "+v"(tid));
    const int wid = __builtin_amdgcn_readfirstlane(tid >> 6), lane = tid & 63, wr = wid >> 2, wc = wid & 3, fr = lane & 15, fq = lane >> 4;
    constexpr unsigned EB = FP8 ? 1u : 2u;
    const int K = g.K, nt = FP8 ? K / 128 : K / BK;
    unsigned voffA, voffB;
    { int R, C; stage_rc(tid * 16, R, C); const int Rb = (R & ~31) + perm32(R & 31);
      voffA = (unsigned)(R * K) * EB + (unsigned)C * 2u; voffB = (unsigned)(Rb * K) * EB + (unsigned)C * 2u; }
    const unsigned r64 = 64u * (unsigned)K * EB;
    const unsigned kstep = (unsigned)(BK * 2);
    const unsigned hstep = (unsigned)HALF * K * EB;
    const unsigned tstep = 2 * hstep;
    unsigned char* wsb = g.ws; asm volatile("" : "+s"(wsb));
    const unsigned ldsw = (unsigned)wid * 1024u;
    const int aoff = lds_byte(wr * 64 + fr, fq * 8), boff = lds_byte(wc * 32 + fr, fq * 8);
#define PG8_SA(b, h) (((b) * 2 + (h)) * HTB)
#define PG8_SB(b, h) ((4 + (b) * 2 + (h)) * HTB)
#define PG8_STAGE(bufoff, goff, voff) do { _Pragma("unroll") for (int _i = 0; _i < 2; ++_i) \
        __builtin_amdgcn_global_load_lds((const unsigned*)(wsb + (unsigned)((goff) + _i * r64 + (voff))), (LAS unsigned*)(lds + (bufoff) + ldsw + _i * 8192), 16, 0, 0); } while (0)
#define PG8_LDA(dst, b, h) do { _Pragma("unroll") for (int m = 0; m < 4; ++m) _Pragma("unroll") for (int k = 0; k < 2; ++k) dst[m][k] = *(const LAS bf16x8*)(lds + PG8_SA(b, h) + aoff + m * 2048 + k * 1024); } while (0)
#define PG8_LDB(dst, b, h) do { _Pragma("unroll") for (int n = 0; n < 2; ++n) _Pragma("unroll") for (int k = 0; k < 2; ++k) dst[n][k] = *(const LAS bf16x8*)(lds + PG8_SB(b, h) + boff + n * 2048 + k * 1024); } while (0)
#define PG8_MMA(ai, bj, At, Bt) do { __builtin_amdgcn_s_setprio(1); _Pragma("unroll") for (int m = 0; m < 4; ++m) _Pragma("unroll") for (int n = 0; n < 2; ++n) { \
        if constexpr (FP8) { const v8i _bb = __builtin_shufflevector(__builtin_bit_cast(v4i, Bt[n][0]), __builtin_bit_cast(v4i, Bt[n][1]), 0, 1, 2, 3, 4, 5, 6, 7), \
                                       _aa = __builtin_shufflevector(__builtin_bit_cast(v4i, At[m][0]), __builtin_bit_cast(v4i, At[m][1]), 0, 1, 2, 3, 4, 5, 6, 7); \
            asm volatile("v_mfma_scale_f32_16x16x128_f8f6f4 %0, %1, %2, %0, %3, %3 op_sel_hi:[0,0,0]" : "+v"(acc[ai][bj][m][n]) : "v"(_bb), "v"(_aa), "v"(0x7f7f7f7f)); }   \
        else { _Pragma("unroll") for (int k = 0; k < 2; ++k) acc[ai][bj][m][n] = __builtin_amdgcn_mfma_f32_16x16x32_bf16(Bt[n][k], At[m][k], acc[ai][bj][m][n], 0, 0, 0); } } \
        __builtin_amdgcn_s_setprio(0); } while (0)
#define PG8_WAIT_V(n) asm volatile("s_waitcnt vmcnt(" #n ")" ::: "memory")
#define PG8_WAIT_L(n) asm volatile("s_waitcnt lgkmcnt(" #n ")" ::: "memory")
#define PG8_BAR __builtin_amdgcn_s_barrier()
#define PG8_SCHED __builtin_amdgcn_sched_barrier(0)
#define PG8_BPTR(u) (g.boff + (unsigned)((u).e * g.N + (u).pn * BM) * (unsigned)K * EB)
    Unit cur, nxt; int ui = 0;
    if (!S.next(0, cur)) return;
    f32x4 acc[2][2][4][2];
#pragma unroll
    for (int a = 0; a < 2; ++a)
#pragma unroll
        for (int b = 0; b < 2; ++b)
#pragma unroll
            for (int m = 0; m < 4; ++m)
#pragma unroll
                for (int n = 0; n < 2; ++n) acc[a][b][m][n] = (f32x4){0.f, 0.f, 0.f, 0.f};
    bf16x8 At[4][2], B0[2][2], B1[2][2];
    unsigned cA = g.aoff + (unsigned)cur.pm * tstep, cB = PG8_BPTR(cur);
    PG8_STAGE(PG8_SB(0, 0), cB, voffB); PG8_STAGE(PG8_SB(0, 1), cB + hstep, voffB); PG8_STAGE(PG8_SA(0, 0), cA, voffA); PG8_STAGE(PG8_SA(0, 1), cA + hstep, voffA);
    if (wr == 1) PG8_BAR;
    PG8_WAIT_V(2); PG8_BAR;
    PG8_STAGE(PG8_SB(1, 0), cB + kstep, voffB); PG8_STAGE(PG8_SA(1, 0), cA + kstep, voffA); PG8_STAGE(PG8_SB(1, 1), cB + hstep + kstep, voffB);
    PG8_WAIT_V(6); PG8_BAR;
    for (;;) {
        const bool has_next = S.next(ui + 1, nxt);
        const unsigned nA = has_next ? g.aoff + (unsigned)nxt.pm * tstep : cA, nB = has_next ? PG8_BPTR(nxt) : cB;
        for (int t = 0; t < nt; t += 2) {
            const bool last = (t == nt - 2);
            const unsigned a1 = cA + (unsigned)(t + 1) * kstep;
            const unsigned a2 = last ? nA : cA + (unsigned)(t + 2) * kstep, b2 = last ? nB : cB + (unsigned)(t + 2) * kstep;
            const unsigned a3 = a2 + kstep, b3 = b2 + kstep;
            PG8_LDB(B0, 0, 0); PG8_LDB(B1, 0, 1); PG8_SCHED; PG8_LDA(At, 0, 0); PG8_STAGE(PG8_SA(1, 1), a1 + hstep, voffA);
            PG8_WAIT_V(8); PG8_WAIT_L(0); PG8_BAR; PG8_MMA(0, 0, At, B0); PG8_MMA(0, 1, At, B1); PG8_BAR; PG8_SCHED;
            PG8_LDA(At, 0, 1); PG8_STAGE(PG8_SB(0, 0), b2, voffB); PG8_STAGE(PG8_SB(0, 1), b2 + hstep, voffB); PG8_STAGE(PG8_SA(0, 0), a2, voffA);
            PG8_WAIT_V(8); PG8_WAIT_L(0); PG8_BAR; PG8_MMA(1, 0, At, B0); PG8_MMA(1, 1, At, B1); PG8_BAR; PG8_SCHED;
            PG8_LDB(B0, 1, 0); PG8_LDB(B1, 1, 1); PG8_SCHED; PG8_LDA(At, 1, 0); PG8_STAGE(PG8_SA(0, 1), a2 + hstep, voffA);
            PG8_WAIT_V(8); PG8_WAIT_L(0); PG8_BAR; PG8_MMA(0, 0, At, B0); PG8_MMA(0, 1, At, B1); PG8_BAR; PG8_SCHED;
            PG8_LDA(At, 1, 1); PG8_STAGE(PG8_SB(1, 0), b3, voffB); PG8_STAGE(PG8_SB(1, 1), b3 + hstep, voffB); PG8_STAGE(PG8_SA(1, 0), a3, voffA);
            PG8_WAIT_V(8); PG8_WAIT_L(0); PG8_BAR; PG8_MMA(1, 0, At, B0); PG8_MMA(1, 1, At, B1); PG8_BAR; PG8_SCHED;
        }
        if (wr == 0) PG8_BAR;
        if constexpr (FP8) { PG8_SCHED; asm volatile("s_nop 15\n\ts_nop 7" ::: "memory"); PG8_SCHED; }
        { int t2 = threadIdx.x; asm volatile("" : "+v"(t2)); const int l2 = t2 & 63;
          E(acc, cur, wr, wc, l2 & 15, l2 >> 4); }
        if (!has_next) break;
#pragma unroll
        for (int a = 0; a < 2; ++a)
#pragma unroll
            for (int b = 0; b < 2; ++b)
#pragma unroll
                for (int m = 0; m < 4; ++m)
#pragma unroll
                    for (int n = 0; n < 2; ++n) acc[a][b][m][n] = (f32x4){0.f, 0.f, 0.f, 0.f};
        cur = nxt; cA = nA; cB = nB; ++ui;
        if (wr == 1) PG8_BAR;
    }
    PG8_WAIT_V(0);
    PG8_BAR;
#undef PG8_SA
#undef PG8_SB
#undef PG8_STAGE
#undef PG8_LDA
#undef PG8_LDB
#undef PG8_MMA
#undef PG8_WAIT_V
#undef PG8_WAIT_L
#undef PG8_BAR
#undef PG8_SCHED
#undef PG8_BPTR
}
}

typedef const f32x4 (&AccRef)[2][2][4][2];
template <class TT> __device__ __forceinline__ TT& wsat(unsigned char* ws, unsigned off) { return *(TT*)(ws + off); }
__device__ __forceinline__ v4u pack8(f32x4 a, f32x4 b, float s) { v4u w; w.x = pk2(a.x * s, a.y * s); w.y = pk2(a.z * s, a.w * s); w.z = pk2(b.x * s, b.y * s); w.w = pk2(b.z * s, b.w * s); return w; }
__device__ __forceinline__ float ssq8(f32x4 a, f32x4 b, float s) { a = a * s; b = b * s; return (a.x * a.x + a.y * a.y) + (a.z * a.z + a.w * a.w) + (b.x * b.x + b.y * b.y) + (b.z * b.z + b.w * b.w); }
__device__ __forceinline__ float fq_sum(float v) { v += __shfl_xor(v, 16); v += __shfl_xor(v, 32); return v; }
constexpr int EPI_LDS_OFF = 131072;
__device__ __forceinline__ void vt_store(unsigned char* ws, LAS unsigned char* lds, int wid, unsigned vt_off, f32x4 a, f32x4 b, float s, int fr, int fq) {
    LAS bf16* scr = (LAS bf16*)(lds + EPI_LDS_OFF + wid * 1024);
    const int p = permk(fr), lane = fq * 16 + fr;
    LAS bf16* w = scr + (8 * fq) * 16 + p;
    w[0 * 16] = (bf16)f2bf(a.x * s); w[1 * 16] = (bf16)f2bf(a.y * s); w[2 * 16] = (bf16)f2bf(a.z * s); w[3 * 16] = (bf16)f2bf(a.w * s);
    w[4 * 16] = (bf16)f2bf(b.x * s); w[5 * 16] = (bf16)f2bf(b.y * s); w[6 * 16] = (bf16)f2bf(b.z * s); w[7 * 16] = (bf16)f2bf(b.w * s);
    asm volatile("s_waitcnt lgkmcnt(0)" ::: "memory");
    const v4u x = *(const LAS v4u*)(scr + (lane >> 1) * 16 + (lane & 1) * 8);
    wsat<v4u>(ws, vt_off + ((unsigned)(lane >> 1) * SEQ + (lane & 1) * 8) * 2u) = x;
    asm volatile("s_waitcnt lgkmcnt(0)" ::: "memory");
}
#define EPI_ROW(ai, m) ((unsigned)(u.pm * 256 + (ai) * 128 + wr * 64 + (m) * 16 + fr))
#define EPI_FOR_AI _Pragma("unroll") for (int ai = 0; ai < 2; ++ai)
#define EPI_FOR_M _Pragma("unroll") for (int m = 0; m < 4; ++m)
constexpr unsigned OA(size_t a) { return (unsigned)(WS_AR + a); }
__device__ __forceinline__ void epi_rstd16(unsigned char* ws, const pg8::Unit& u, int wr, int fr, int fq, float (&rs)[8]) {
    f32x4 part[8];
    EPI_FOR_AI EPI_FOR_M part[ai * 4 + m] = wsat<f32x4>(ws, (unsigned)WS_SSQ + EPI_ROW(ai, m) * 64u + (unsigned)fq * 16u);
#pragma unroll
    for (int i = 0; i < 8; ++i) { const float t = fq_sum((part[i].x + part[i].y) + (part[i].z + part[i].w)); rs[i] = 1.0f / sqrtf(t * (1.f / D) + EPS); }
}
__device__ __forceinline__ void epi_rstd4(unsigned char* ws, unsigned off, float invn, const pg8::Unit& u, int wr, int fr, float (&rs)[8]) {
    f32x4 part[8];
    EPI_FOR_AI EPI_FOR_M part[ai * 4 + m] = wsat<f32x4>(ws, off + EPI_ROW(ai, m) * 16u);
#pragma unroll
    for (int i = 0; i < 8; ++i) rs[i] = 1.0f / sqrtf(((part[i].x + part[i].y) + (part[i].z + part[i].w)) * invn + EPS);
}
__device__ __forceinline__ float clamp448(float v) { return __builtin_amdgcn_fmed3f(v, -448.f, 448.f); }
__device__ __forceinline__ unsigned pk4_fp8(float a, float b, float c, float d) { int w = __builtin_amdgcn_cvt_pk_fp8_f32(clamp448(a), clamp448(b), 0, false); w = __builtin_amdgcn_cvt_pk_fp8_f32(clamp448(c), clamp448(d), w, true); return (unsigned)w; }
constexpr float FP8_WS_GU = 64.f, FP8_WS_DN = 128.f, FP8_AS = 4.f;

__device__ const float RFB[16] = {1.591549431e-01f, 8.949940161e-02f, 5.032921210e-02f, 2.830219583e-02f, 1.591549431e-02f, 8.949940161e-03f, 5.032921210e-03f, 2.830219583e-03f, 1.591549431e-03f, 8.949940161e-04f, 5.032921210e-04f, 2.830219583e-04f, 1.591549431e-04f, 8.949940161e-05f, 5.032921210e-05f, 2.830219583e-05f};
__device__ const float RFC[32] = {1.591549431e-01f, 1.193493702e-01f, 8.949940161e-02f, 6.711508301e-02f, 5.032921210e-02f, 3.774158472e-02f, 2.830219583e-02f, 2.122365276e-02f, 1.591549431e-02f, 1.193493702e-02f, 8.949940161e-03f, 6.711508301e-03f, 5.032921210e-03f, 3.774158472e-03f, 2.830219583e-03f, 2.122365276e-03f, 1.591549431e-03f, 1.193493702e-03f, 8.949940161e-04f, 6.711508301e-04f, 5.032921210e-04f, 3.774158472e-04f, 2.830219583e-04f, 2.122365276e-04f, 1.591549431e-04f, 1.193493702e-04f, 8.949940161e-05f, 6.711508301e-05f, 5.032921210e-05f, 3.774158472e-05f, 2.830219583e-05f, 2.122365276e-05f};
__device__ __forceinline__ void rope_cs8(float posf, const float (&rf)[8], f32x4& c0, f32x4& c1, f32x4& s0, f32x4& s1) {
    float c[8], s[8];
#pragma unroll
    for (int e = 0; e < 8; ++e) { const float r = __builtin_amdgcn_fractf(posf * rf[e]); c[e] = __builtin_amdgcn_cosf(r); s[e] = __builtin_amdgcn_sinf(r); }
    c0 = (f32x4){c[0], c[1], c[2], c[3]}; c1 = (f32x4){c[4], c[5], c[6], c[7]}; s0 = (f32x4){s[0], s[1], s[2], s[3]}; s1 = (f32x4){s[4], s[5], s[6], s[7]};
}
struct EpiEvenIn {
    unsigned char* ws; LAS unsigned char* lds; const int* pos;
    __device__ __forceinline__ void operator()(AccRef acc, const pg8::Unit& u, int wr, int wc, int fr, int fq) const {
        const int pn = u.pn; const unsigned c8 = 32 * wc + 8 * fq;
        float rsv[8]; epi_rstd16(ws, u, wr, fr, fq, rsv);
        int posv[8]; float rf[8];
        if (pn == 7 && wc == 0) { EPI_FOR_AI EPI_FOR_M posv[ai * 4 + m] = pos[EPI_ROW(ai, m)];
#pragma unroll
            for (int e = 0; e < 8; ++e) rf[e] = RFB[8 * (fq & 1) + e]; }
        EPI_FOR_AI {
            EPI_FOR_M { const unsigned row = EPI_ROW(ai, m); const float rs = rsv[ai * 4 + m];
            if (pn < 4) { const unsigned o = (pn < 2 ? OA(AR_QA) : OA(AR_KA)) + (row * 512u + (pn & 1) * 256u + c8) * 2u; const float s = pn < 2 ? rs * (0.125f * LOG2E) : rs;
                wsat<v4u>(ws, o) = pack8(acc[ai][0][m][0], acc[ai][0][m][1], s); wsat<v4u>(ws, o + 256) = pack8(acc[ai][1][m][0], acc[ai][1][m][1], s); }
            else if (pn < 6) { const unsigned r16 = row - fr, b = r16 / SEQ, s16 = r16 % SEQ;
                _Pragma("unroll") for (int bj = 0; bj < 2; ++bj) { const unsigned cc = (pn - 4) * 256 + 128 * bj + 32 * wc, h = cc >> 6, d0 = cc & 63;
                    vt_store(ws, lds, wr * 4 + wc, OA(AR_VAT) + (((b * 8 + h) * 64 + d0) * SEQ + s16) * 2u, acc[ai][bj][m][0], acc[ai][bj][m][1], rs, fr, fq); } }
            else if (pn == 6) { const unsigned o = OA(AR_CQ) + (row * 256u + c8) * 2u;
                wsat<v4u>(ws, o) = pack8(acc[ai][0][m][0], acc[ai][0][m][1], rs); wsat<v4u>(ws, o + 256) = pack8(acc[ai][1][m][0], acc[ai][1][m][1], rs);
                const float ss = fq_sum(ssq8(acc[ai][0][m][0], acc[ai][0][m][1], rs) + ssq8(acc[ai][1][m][0], acc[ai][1][m][1], rs));
                if (fq == 0) wsat<float>(ws, (unsigned)WS_SSQQ + (row * 4u + wc) * 4u) = ss; }
            else { const unsigned o = OA(AR_CKV) + (row * 256u + c8) * 2u;
                wsat<v4u>(ws, o) = pack8(acc[ai][0][m][0], acc[ai][0][m][1], rs); wsat<v4u>(ws, o + 256) = (v4u){0u, 0u, 0u, 0u};
                const float ss = fq_sum(ssq8(acc[ai][0][m][0], acc[ai][0][m][1], rs));
                if (fq == 0) wsat<float>(ws, (unsigned)WS_SSQKV + (row * 4u + wc) * 4u) = ss;
                if (wc == 0) {
                    const f32x4 a = acc[ai][1][m][0] * rs, bq = acc[ai][1][m][1] * rs;
                    float own[8] = {a.x, a.y, a.z, a.w, bq.x, bq.y, bq.z, bq.w}; float o8[8];
                    const unsigned j0 = 8 * (fq & 1);
                    f32x4 c0, c1, s0, s1; rope_cs8((float)posv[ai * 4 + m], rf, c0, c1, s0, s1);
                    const float cs[8] = {c0.x, c0.y, c0.z, c0.w, c1.x, c1.y, c1.z, c1.w}, sn[8] = {s0.x, s0.y, s0.z, s0.w, s1.x, s1.y, s1.z, s1.w};
                    _Pragma("unroll") for (int e = 0; e < 8; ++e) { const float oth = __shfl_xor(own[e], 32); o8[e] = fq < 2 ? own[e] * cs[e] - oth * sn[e] : oth * sn[e] + own[e] * cs[e]; }
                    v4u w; w.x = pk2(o8[0], o8[1]); w.y = pk2(o8[2], o8[3]); w.z = pk2(o8[4], o8[5]); w.w = pk2(o8[6], o8[7]);
                    const unsigned kb = OA(AR_KB) + (row * 768u + 64 + 16 * (fq >> 1) + j0) * 2u;
                    _Pragma("unroll") for (int h = 0; h < 8; ++h) wsat<v4u>(ws, kb + h * 192) = w; } }
            }
        }
    }
};
struct EpiUq {
    unsigned char* ws; const int* pos;
    __device__ __forceinline__ void operator()(AccRef acc, const pg8::Unit& u, int wr, int wc, int fr, int fq) const {
        const int pn = u.pn; const float sc = 0.10206207261596575f * LOG2E;
        float rsv[8]; epi_rstd4(ws, (unsigned)WS_SSQQ, 1.f / 256, u, wr, fr, rsv);
        int posv[8]; float rf[8];
        if (pn == 2) { EPI_FOR_AI EPI_FOR_M posv[ai * 4 + m] = pos[EPI_ROW(ai, m)];
#pragma unroll
            for (int e = 0; e < 8; ++e) rf[e] = RFB[8 * (fq & 1) + e]; }
        EPI_FOR_AI {
            EPI_FOR_M { const unsigned row = EPI_ROW(ai, m); const float rs = rsv[ai * 4 + m] * sc; const unsigned qrow = OA(AR_QB) + row * 1536u;
            if (pn < 2) { _Pragma("unroll") for (int bj = 0; bj < 2; ++bj) { const unsigned h = 4 * pn + 2 * bj + (wc >> 1), d = 32 * (wc & 1) + 8 * fq;
                    wsat<v4u>(ws, qrow + (h * 96 + d) * 2u) = pack8(acc[ai][bj][m][0], acc[ai][bj][m][1], rs); } }
            else { const unsigned head = 2 * wc + (fq >> 1), j0 = 8 * (fq & 1);
                f32x4 c0, c1, s0, s1; rope_cs8((float)posv[ai * 4 + m], rf, c0, c1, s0, s1);
                const f32x4 x10 = acc[ai][0][m][0], x11 = acc[ai][0][m][1], x20 = acc[ai][1][m][0], x21 = acc[ai][1][m][1];
                wsat<v4u>(ws, qrow + (head * 96 + 64 + j0) * 2u) = pack8(x10 * c0 - x20 * s0, x11 * c1 - x21 * s1, rs);
                wsat<v4u>(ws, qrow + (head * 96 + 80 + j0) * 2u) = pack8(x10 * s0 + x20 * c0, x11 * s1 + x21 * c1, rs); }
            }
        }
    }
};
struct EpiUkv {
    unsigned char* ws; LAS unsigned char* lds;
    __device__ __forceinline__ void operator()(AccRef acc, const pg8::Unit& u, int wr, int wc, int fr, int fq) const {
        float rsv[8]; epi_rstd4(ws, (unsigned)WS_SSQKV, 1.f / 128, u, wr, fr, rsv);
        EPI_FOR_AI EPI_FOR_M { const unsigned row = EPI_ROW(ai, m); const float rs = rsv[ai * 4 + m]; const unsigned r16 = row - fr, b = r16 / SEQ, s16 = r16 % SEQ;
            _Pragma("unroll") for (int bj = 0; bj < 2; ++bj) { const unsigned h = 2 * u.pn + bj;
                if (wc < 2) wsat<v4u>(ws, OA(AR_KB) + (row * 768u + h * 96 + 32 * wc + 8 * fq) * 2u) = pack8(acc[ai][bj][m][0], acc[ai][bj][m][1], rs);
                else vt_store(ws, lds, wr * 4 + wc, OA(AR_VBT) + (((b * 8 + h) * 64 + 32 * (wc - 2)) * SEQ + s16) * 2u, acc[ai][bj][m][0], acc[ai][bj][m][1], rs, fr, fq); }
        }
    }
};
template <bool W8, bool WB = true> struct EpiRes {
    unsigned char* ws; const float* res; float oscale;
    __device__ __forceinline__ void operator()(AccRef acc, const pg8::Unit& u, int wr, int wc, int fr, int fq) const {
#if H_BF16
        v4u rv[8][2];
        EPI_FOR_AI EPI_FOR_M _Pragma("unroll") for (int bj = 0; bj < 2; ++bj) rv[ai * 4 + m][bj] = wsat<v4u>(ws, (unsigned)WS_HB + (EPI_ROW(ai, m) * 1024u + u.pn * 256 + 128 * bj + 32 * wc + 8 * fq) * 2u);
        EPI_FOR_AI EPI_FOR_M { const unsigned row = EPI_ROW(ai, m);
            float ss = 0.f;
            _Pragma("unroll") for (int bj = 0; bj < 2; ++bj) { const unsigned e = row * 1024u + u.pn * 256 + 128 * bj + 32 * wc + 8 * fq; const v4u t = rv[ai * 4 + m][bj];
                const f32x4 h0 = (f32x4){bf2f(t.x & 0xffffu), bf2f(t.x >> 16), bf2f(t.y & 0xffffu), bf2f(t.y >> 16)} + acc[ai][bj][m][0] * oscale;
                const f32x4 h1 = (f32x4){bf2f(t.z & 0xffffu), bf2f(t.z >> 16), bf2f(t.w & 0xffffu), bf2f(t.w >> 16)} + acc[ai][bj][m][1] * oscale;
                if (W8) { v2u w8; w8.x = pk4_fp8(h0.x, h0.y, h0.z, h0.w); w8.y = pk4_fp8(h1.x, h1.y, h1.z, h1.w); wsat<v2u>(ws, OA(AR_HB8) + e) = w8; }
                wsat<v4u>(ws, (unsigned)WS_HB + e * 2u) = pack8(h0, h1, 1.f);
                if (WB) ss += ssq8(h0, h1, 1.f); }
            if (WB) { ss = fq_sum(ss);
            if (fq == 0) wsat<float>(ws, (unsigned)WS_SSQ + (row * 16u + 4 * u.pn + wc) * 4u) = ss; }
        }
#else
        EPI_FOR_AI {
            f32x4 rv[4][2][2];
            EPI_FOR_M _Pragma("unroll") for (int bj = 0; bj < 2; ++bj) { const unsigned e = EPI_ROW(ai, m) * 1024u + u.pn * 256 + 128 * bj + 32 * wc + 8 * fq;
                const f32x4* rp = (const f32x4*)((const unsigned char*)res + e * 4u); rv[m][bj][0] = rp[0]; rv[m][bj][1] = rp[1]; }
            EPI_FOR_M { const unsigned row = EPI_ROW(ai, m);
            float ss = 0.f;
            _Pragma("unroll") for (int bj = 0; bj < 2; ++bj) { const unsigned e = row * 1024u + u.pn * 256 + 128 * bj + 32 * wc + 8 * fq;
                const f32x4 h0 = rv[m][bj][0] + acc[ai][bj][m][0] * oscale, h1 = rv[m][bj][1] + acc[ai][bj][m][1] * oscale;
                if (W8) { v2u w8; w8.x = pk4_fp8(h0.x, h0.y, h0.z, h0.w); w8.y = pk4_fp8(h1.x, h1.y, h1.z, h1.w); wsat<v2u>(ws, OA(AR_HB8) + e) = w8; }
                wsat<f32x4>(ws, (unsigned)WS_H + e * 4u) = h0; wsat<f32x4>(ws, (unsigned)WS_H + e * 4u + 16) = h1;
                if (WB) { wsat<v4u>(ws, (unsigned)WS_HB + e * 2u) = pack8(h0, h1, 1.f); ss += ssq8(h0, h1, 1.f); } }
            if (WB) { ss = fq_sum(ss);
            if (fq == 0) wsat<float>(ws, (unsigned)WS_SSQ + (row * 16u + 4 * u.pn + wc) * 4u) = ss; }
            }
        }
#endif
    }
};
struct EpiOddIn {
    unsigned char* ws; LAS unsigned char* lds; const int* pos;
    __device__ __forceinline__ void operator()(AccRef acc, const pg8::Unit& u, int wr, int wc, int fr, int fq) const {
        const int pn = u.pn;
        float rsv[8]; epi_rstd16(ws, u, wr, fr, fq, rsv);
        int posv[8]; float rf[8];
        if (pn < 8) { EPI_FOR_AI EPI_FOR_M posv[ai * 4 + m] = pos[EPI_ROW(ai, m)];
#pragma unroll
            for (int e = 0; e < 8; ++e) rf[e] = RFC[8 * fq + e]; }
        EPI_FOR_AI {
            EPI_FOR_M { const unsigned row = EPI_ROW(ai, m); const float rs = rsv[ai * 4 + m];
            if (pn < 8) { const unsigned mm = 4 * (pn & 3) + wc, j0 = 8 * fq; const float s = pn < 4 ? rs * (0.125f * LOG2E) : rs;
                f32x4 c0, c1, s0, s1; rope_cs8((float)posv[ai * 4 + m], rf, c0, c1, s0, s1);
                const f32x4 x10 = acc[ai][0][m][0], x11 = acc[ai][0][m][1], x20 = acc[ai][1][m][0], x21 = acc[ai][1][m][1];
                const unsigned o = (pn < 4 ? OA(AR_QC) : OA(AR_KC)) + (row * 1024u + (mm >> 1) * 128 + (mm & 1) * 64 + j0) * 2u;
                wsat<v4u>(ws, o) = pack8(x10 * c0 - x20 * s0, x11 * c1 - x21 * s1, s);
                wsat<v4u>(ws, o + 64) = pack8(x10 * s0 + x20 * c0, x11 * s1 + x21 * c1, s); }
            else { const unsigned r16 = row - fr, b = r16 / SEQ, s16 = r16 % SEQ;
                _Pragma("unroll") for (int bj = 0; bj < 2; ++bj) { const unsigned h = 2 * (pn - 8) + bj;
                    vt_store(ws, lds, wr * 4 + wc, OA(AR_VCT) + (((b * 8 + h) * 128 + 32 * wc) * SEQ + s16) * 2u, acc[ai][bj][m][0], acc[ai][bj][m][1], rs, fr, fq); } }
            }
        }
    }
};
__device__ __forceinline__ float silu_mul(float g2, float u2) { return g2 * u2 * __builtin_amdgcn_rcpf(1.f + __builtin_amdgcn_exp2f(-g2)); }
template <bool NORM> struct EpiSwigluFp8 {
    unsigned char* ws; unsigned aoff; int ldc;
    __device__ __forceinline__ void operator()(AccRef acc, const pg8::Unit& u, int wr, int wc, int fr, int fq) const {
        float rsv[8];
        if (NORM) epi_rstd16(ws, u, wr, fr, fq, rsv);
        EPI_FOR_AI EPI_FOR_M { const unsigned row = EPI_ROW(ai, m);
            const float rs = (NORM ? rsv[ai * 4 + m] : 1.f) * (1.f / FP8_WS_GU);
            const f32x4 g0 = acc[ai][0][m][0] * (rs * LOG2E), g1 = acc[ai][0][m][1] * (rs * LOG2E), u0 = acc[ai][1][m][0] * (rs * (FP8_AS / LOG2E)), u1 = acc[ai][1][m][1] * (rs * (FP8_AS / LOG2E));
            v2u w; w.x = pk4_fp8(silu_mul(g0.x, u0.x), silu_mul(g0.y, u0.y), silu_mul(g0.z, u0.z), silu_mul(g0.w, u0.w));
            w.y = pk4_fp8(silu_mul(g1.x, u1.x), silu_mul(g1.y, u1.y), silu_mul(g1.z, u1.z), silu_mul(g1.w, u1.w));
            wsat<v2u>(ws, aoff + row * (unsigned)ldc + 128 * u.pn + 32 * wc + 8 * fq) = w;
        }
    }
};
template <bool NORM> struct EpiSwiglu {
    unsigned char* ws; unsigned aoff; int ldc;
    __device__ __forceinline__ void operator()(AccRef acc, const pg8::Unit& u, int wr, int wc, int fr, int fq) const {
        float rsv[8];
        if (NORM) epi_rstd16(ws, u, wr, fr, fq, rsv);
        EPI_FOR_AI EPI_FOR_M { const unsigned row = EPI_ROW(ai, m);
            const float rs = NORM ? rsv[ai * 4 + m] : 1.f;
            const f32x4 g0 = acc[ai][0][m][0] * (rs * LOG2E), g1 = acc[ai][0][m][1] * (rs * LOG2E), u0 = acc[ai][1][m][0] * (rs * (1.f / LOG2E)), u1 = acc[ai][1][m][1] * (rs * (1.f / LOG2E));
            v4u w; w.x = pk2(silu_mul(g0.x, u0.x), silu_mul(g0.y, u0.y)); w.y = pk2(silu_mul(g0.z, u0.z), silu_mul(g0.w, u0.w));
            w.z = pk2(silu_mul(g1.x, u1.x), silu_mul(g1.y, u1.y)); w.w = pk2(silu_mul(g1.z, u1.z), silu_mul(g1.w, u1.w));
            wsat<v4u>(ws, aoff + (row * (unsigned)ldc + 128 * u.pn + 32 * wc + 8 * fq) * 2u) = w;
        }
    }
};
template <bool NORM, bool W8, bool A8> struct EpiSwigluX {
    unsigned char* ws; unsigned aoff; int ldc;
    __device__ __forceinline__ void operator()(AccRef acc, const pg8::Unit& u, int wr, int wc, int fr, int fq) const {
        float rsv[8];
        if (NORM) epi_rstd16(ws, u, wr, fr, fq, rsv);
        EPI_FOR_AI EPI_FOR_M { const unsigned row = EPI_ROW(ai, m);
            const float rs = (NORM ? rsv[ai * 4 + m] : 1.f) * (W8 ? 1.f / FP8_WS_GU : 1.f), us = rs * (A8 ? FP8_AS : 1.f) * (1.f / LOG2E);
            const f32x4 g0 = acc[ai][0][m][0] * (rs * LOG2E), g1 = acc[ai][0][m][1] * (rs * LOG2E), u0 = acc[ai][1][m][0] * us, u1 = acc[ai][1][m][1] * us;
            if (A8) { v2u w; w.x = pk4_fp8(silu_mul(g0.x, u0.x), silu_mul(g0.y, u0.y), silu_mul(g0.z, u0.z), silu_mul(g0.w, u0.w));
                w.y = pk4_fp8(silu_mul(g1.x, u1.x), silu_mul(g1.y, u1.y), silu_mul(g1.z, u1.z), silu_mul(g1.w, u1.w));
                wsat<v2u>(ws, aoff + row * (unsigned)ldc + 128 * u.pn + 32 * wc + 8 * fq) = w; }
            else { v4u w; w.x = pk2(silu_mul(g0.x, u0.x), silu_mul(g0.y, u0.y)); w.y = pk2(silu_mul(g0.z, u0.z), silu_mul(g0.w, u0.w));
                w.z = pk2(silu_mul(g1.x, u1.x), silu_mul(g1.y, u1.y)); w.w = pk2(silu_mul(g1.z, u1.z), silu_mul(g1.w, u1.w));
                wsat<v4u>(ws, aoff + (row * (unsigned)ldc + 128 * u.pn + 32 * wc + 8 * fq) * 2u) = w; }
        }
    }
};
struct EpiMoeDown {
    unsigned char* ws; float oscale;
    __device__ __forceinline__ void operator()(AccRef acc, const pg8::Unit& u, int wr, int wc, int fr, int fq) const {
        int tiv[8]; float gtv[8];
        EPI_FOR_AI EPI_FOR_M { const unsigned row = EPI_ROW(ai, m); tiv[ai * 4 + m] = wsat<int>(ws, (unsigned)WS_TOKI + row * 4u); gtv[ai * 4 + m] = wsat<float>(ws, (unsigned)WS_GATE + row * 4u); }
        EPI_FOR_AI EPI_FOR_M { const int ti = tiv[ai * 4 + m];
            if (ti >= 0) { const float gt = gtv[ai * 4 + m] * oscale; const unsigned o = OA(AR_Y) + (((unsigned)(ti & 1) * T + (unsigned)(ti >> 1)) * 1024u + u.pn * 256 + 32 * wc + 8 * fq) * 2u;
                wsat<v4u>(ws, o) = pack8(acc[ai][0][m][0], acc[ai][0][m][1], gt); wsat<v4u>(ws, o + 256) = pack8(acc[ai][1][m][0], acc[ai][1][m][1], gt); }
        }
    }
};

__device__ __forceinline__ float xhalf_max(float m) { auto rr = __builtin_amdgcn_permlane32_swap(__float_as_uint(m), __float_as_uint(m), false, false); return fmaxf(__uint_as_float(rr[0]), __uint_as_float(rr[1])); }
__device__ __forceinline__ float xhalf_sum(float m) { auto rr = __builtin_amdgcn_permlane32_swap(__float_as_uint(m), __float_as_uint(m), false, false); return __uint_as_float(rr[0]) + __uint_as_float(rr[1]); }
__device__ __forceinline__ float max3f(float a, float b, float c) { float r; asm("v_max3_f32 %0, %1, %2, %3" : "=v"(r) : "v"(a), "v"(b), "v"(c)); return r; }
__device__ __forceinline__ int crow(int r, int hi) { return (r & 3) + 8 * (r >> 2) + 4 * hi; }
constexpr int ATT_TAB_OFF = 57344;
constexpr int ATT_TAB_N = 648, ATT_TAB_BYTES = 4 * ATT_TAB_N * 4;

struct CvState { int done, step, next; };
#ifndef MOE_CONV_PERIOD
#define MOE_CONV_PERIOD 7
#endif
template <int MODE>
__device__ __forceinline__ void attn_unit(const P& p, LAS unsigned char* lds, int layer, int b, int h, int qb, float lam_init, float lam, CvState& cs, int cvid) {
    constexpr int DK = MODE == 0 ? 64 : (MODE == 1 ? 96 : 128), DQK = MODE == 1 ? 96 : 64, DV = MODE == 2 ? 128 : 64;
    constexpr int PITCH = MODE == 0 ? 512 : (MODE == 1 ? 768 : 1024), HD = MODE == 0 ? 64 : (MODE == 1 ? 96 : 128);
    constexpr int KROW = DK * 2 + 16, VROW = 144, KST = 64 * KROW, VST = DV * VROW, STAGE = KST + VST;
    constexpr int NKP = 64 * DK / 8, KPT = (NKP + 511) / 512, NVP = DV * 8, VPT = NVP / 512, NS = DQK / 16, NDV = DV / 32, CPR = DK / 8;
    static_assert(3 * STAGE <= (MODE == 0 ? ATT_TAB_OFF : LDSCTL_OFF) && 65536 <= LDSCTL_OFF && ATT_TAB_OFF + ATT_TAB_BYTES <= 69632, "attention LDS map");
    int tid = threadIdx.x; asm volatile("" : "+v"(tid));
    const int lane = tid & 63, w = __builtin_amdgcn_readfirstlane(tid >> 6), l31 = lane & 31, hi = lane >> 5;
    const int i2 = layer >> 1;
    unsigned char* ar = p.ws + WS_AR;
    const bf16* Q = (const bf16*)(ar + (MODE == 0 ? AR_QA : MODE == 1 ? AR_QB : AR_QC));
    const bf16* Kp = (const bf16*)(ar + (MODE == 0 ? AR_KA : MODE == 1 ? AR_KB : AR_KC));
    const bf16* VT = (const bf16*)(ar + (MODE == 0 ? AR_VAT : MODE == 1 ? AR_VBT : AR_VCT));
    bf16* O = (bf16*)(ar + AR_MIX);
    const int wq = MODE == 2 ? (w & 3) : w, kd0 = MODE == 2 ? (w >> 2) * 64 : 0;
    const int c0 = MODE == 2 ? qb * 2 : qb * 4, cq = c0 + (wq >> 1);
    const int qrow0 = c0 * 64 + 32 * wq;
    const int jhi_u = c0 + (MODE == 2 ? 1 : 3), jlo_u = MODE == 0 ? (c0 > 8 ? c0 - 8 : 0) : 0;
    const int jlo_w = MODE == 0 ? (cq > 8 ? cq - 8 : 0) : 0, jhi_w = cq;
    const bf16* Kg = Kp + (size_t)b * SEQ * PITCH + h * HD;
    const bf16* Vg = VT + (size_t)(b * 8 + h) * DV * SEQ;
    bf16x8 qf[NS];
    { const bf16* qp = Q + (size_t)(b * SEQ + qrow0 + l31) * PITCH + h * HD + kd0 + 8 * hi;
#pragma unroll
      for (int s = 0; s < NS; ++s) qf[s] = *(const bf16x8*)(qp + 16 * s); }
    int btab = 0;
    if (MODE == 0) { LAS float* tab = (LAS float*)(lds + ATT_TAB_OFF); const float* rb = p.relb + ((size_t)i2 * 8 + h) * 513;
        for (int i = tid; i < 4 * ATT_TAB_N; i += 512) { const int c = i / ATT_TAB_N, t = i % ATT_TAB_N + c; int d = 576 - t; d = d < -256 ? -256 : (d > 256 ? 256 : d); tab[i] = rb[d + 256] * LOG2E; }
        const int ql = 32 * (wq & 1) + l31, c = (4 - (ql & 3)) & 3, t00 = 576 - ql + 4 * hi; btab = ATT_TAB_OFF + c * (ATT_TAB_N * 4) + (t00 - c) * 4; }
    constexpr bool KFULL = (NKP % 512) == 0;
    int kgo[KPT], klo[KPT], vgo[VPT], vlo[VPT]; bool kok[KPT];
#pragma unroll
    for (int i = 0; i < KPT; ++i) { const int pc = tid + 512 * i; kok[i] = pc < NKP; const int key = pc / CPR, ch = pc % CPR; kgo[i] = key * PITCH + ch * 8; klo[i] = key * KROW + ch * 16; }
#pragma unroll
    for (int i = 0; i < VPT; ++i) { const int pc = tid + 512 * i, dv = pc >> 3, ch = pc & 7; vgo[i] = dv * SEQ + ch * 8; vlo[i] = KST + dv * VROW + ch * 16; }
    v4u kreg[KPT], vreg[VPT];
#define ATT_LOAD(j) do { _Pragma("unroll") for (int i = 0; i < KPT; ++i) if (KFULL || kok[i]) kreg[i] = *(const v4u*)(Kg + (size_t)(j) * 64 * PITCH + kgo[i]); \
        _Pragma("unroll") for (int i = 0; i < VPT; ++i) vreg[i] = *(const v4u*)(Vg + (j) * 64 + vgo[i]); } while (0)
#define ATT_WRITE(so) do { _Pragma("unroll") for (int i = 0; i < KPT; ++i) if (KFULL || kok[i]) *(LAS v4u*)(lds + (so) + klo[i]) = kreg[i]; \
        _Pragma("unroll") for (int i = 0; i < VPT; ++i) *(LAS v4u*)(lds + (so) + vlo[i]) = vreg[i]; } while (0)
    f32x16 o[NDV];
#pragma unroll
    for (int d = 0; d < NDV; ++d) o[d] = f32x16{};
    constexpr float ATT_THR = 8.f;
    float mrun = 0.f, lrun = 0.f; f32x16 negm = f32x16{};
    ATT_LOAD(jlo_u); ATT_WRITE(0);
    if (jlo_u < jhi_u) ATT_LOAD(jlo_u + 1);
    __syncthreads();
    int sb = 0;
    WItem cw; f32x4 cv[8]; float cg = 0.f, cls = 0.f; int cst = 0, cage = 0; cw.fp8 = 0;
    LAS float* ctl = (LAS float*)(lds + WCONV_LDS_OFF);
    static_assert(MODE == 2 || 3 * STAGE <= WCONV_LDS_OFF, "conversion tile above the K/V stages");
    for (int j = jlo_u; j <= jhi_u; ++j) {
        const int sb1 = (sb == 2 * STAGE) ? 0 : sb + STAGE;
        if (MODE != 2 && cvid >= 0) {
            if (cst == 2) { wconv_lds_read_store(cw, w, lane, ctl); cst = 0; }
            else if (cst == 1 && ++cage >= 2) { wconv_lds_write(cw, w, lane, cv, cg, cls, ctl); cst = 2; }
        }
        if (j < jhi_u) ATT_WRITE(sb1);
        if (j + 1 < jhi_u) ATT_LOAD(j + 2);
        if (MODE != 2 && cvid >= 0) {
            if (cst == 0 && cs.done < MOE_CONV_PER_WG && jhi_u - j >= 3 && cs.step >= cs.next) {
                cw = moe_conv_item(p, layer >> 1, cvid + 256 * cs.done); wconv_load(cw, w, lane, cv, cg, cls); cst = 1; cage = 0; ++cs.done; cs.next = cs.step + MOE_CONV_PERIOD; }
            ++cs.step; }
        if (j >= jlo_w && j <= jhi_w) {
            const LAS unsigned char* Kl = lds + sb; const LAS unsigned char* Vl = Kl + KST;
            f32x16 sa[2];
            { bf16x8 kf[2 * NS];
#pragma unroll
              for (int kh = 0; kh < 2; ++kh)
#pragma unroll
                for (int s = 0; s < NS; ++s) kf[kh * NS + s] = *(const LAS bf16x8*)(Kl + (32 * kh + l31) * KROW + (kd0 + 16 * s + 8 * hi) * 2);
#pragma unroll
              for (int kh = 0; kh < 2; ++kh)
#pragma unroll
                for (int s = 0; s < NS; ++s) sa[kh] = __builtin_amdgcn_mfma_f32_32x32x16_bf16(kf[kh * NS + s], qf[s], s == 0 ? negm : sa[kh], 0, 0, 0); }
            asm volatile("s_nop 15\n\ts_nop 7" : "+v"(sa[0]), "+v"(sa[1]));
            bf16x8 vf[8];
#pragma unroll
            for (int d = 0; d < 2; ++d)
#pragma unroll
                for (int ks = 0; ks < 4; ++ks) vf[d * 4 + ks] = *(const LAS bf16x8*)(Vl + (32 * d + l31) * VROW + (16 * ks + 8 * hi) * 2);
            if (MODE == 0) { const int dc = cq - j;
                if (dc >= 5) { const float bv = *(const LAS float*)(lds + ATT_TAB_OFF);
#pragma unroll
                    for (int r = 0; r < 16; ++r) { sa[0][r] += bv; sa[1][r] += bv; } }
                else { const LAS f32x4* bp = (const LAS f32x4*)(lds + btab - 256 * dc);
#pragma unroll
                    for (int kh = 0; kh < 2; ++kh)
#pragma unroll
                        for (int jq = 0; jq < 4; ++jq) { const f32x4 bb = bp[8 * kh + 2 * jq]; sa[kh][4 * jq] += bb.x; sa[kh][4 * jq + 1] += bb.y; sa[kh][4 * jq + 2] += bb.z; sa[kh][4 * jq + 3] += bb.w; } } }
            float mx = max3f(sa[0][0], sa[1][0], sa[0][1]), my = max3f(sa[1][1], sa[0][2], sa[1][2]);
#pragma unroll
            for (int r = 3; r < 15; r += 2) { mx = max3f(mx, sa[0][r], sa[1][r]); my = max3f(my, sa[0][r + 1], sa[1][r + 1]); }
            mx = max3f(mx, sa[0][15], sa[1][15]); mx = max3f(mx, my, my);
            mx = xhalf_max(mx);
            const bool first = (j == jlo_w);
            if (first || __any(mx > ATT_THR)) {
                const float dl = first ? mx : fmaxf(mx, 0.f);
                mrun += dl;
#pragma unroll
                for (int r = 0; r < 16; ++r) { sa[0][r] -= dl; sa[1][r] -= dl; negm[r] = -mrun; }
                if (!first) { const float alpha = __builtin_amdgcn_exp2f(-dl); lrun *= alpha;
#pragma unroll
                    for (int d = 0; d < NDV; ++d)
#pragma unroll
                        for (int r = 0; r < 16; ++r) o[d][r] *= alpha; }
            }
            float ls = 0.f;
#pragma unroll
            for (int kh = 0; kh < 2; ++kh)
#pragma unroll
                for (int r = 0; r < 16; ++r) { const float e = __builtin_amdgcn_exp2f(sa[kh][r]); sa[kh][r] = e; ls += e; }
            lrun += ls;
            bf16x8 pb[4];
#pragma unroll
            for (int ks = 0; ks < 4; ++ks) { const int kh = ks >> 1, r0 = 8 * (ks & 1); v4u t;
                t.x = pk2(sa[kh][r0 + 0], sa[kh][r0 + 1]); t.y = pk2(sa[kh][r0 + 2], sa[kh][r0 + 3]); t.z = pk2(sa[kh][r0 + 4], sa[kh][r0 + 5]); t.w = pk2(sa[kh][r0 + 6], sa[kh][r0 + 7]);
                pb[ks] = __builtin_bit_cast(bf16x8, t); }
            if (NDV == 4) { bf16x8 vg[8];
#pragma unroll
                for (int d = 0; d < 2; ++d)
#pragma unroll
                    for (int ks = 0; ks < 4; ++ks) vg[d * 4 + ks] = *(const LAS bf16x8*)(Vl + (32 * (d + 2) + l31) * VROW + (16 * ks + 8 * hi) * 2);
#pragma unroll
                for (int d = 0; d < 2; ++d)
#pragma unroll
                    for (int ks = 0; ks < 4; ++ks) o[d] = __builtin_amdgcn_mfma_f32_32x32x16_bf16(vf[d * 4 + ks], pb[ks], o[d], 0, 0, 0);
#pragma unroll
                for (int d = 0; d < 2; ++d)
#pragma unroll
                    for (int ks = 0; ks < 4; ++ks) o[NDV - 2 + d] = __builtin_amdgcn_mfma_f32_32x32x16_bf16(vg[d * 4 + ks], pb[ks], o[NDV - 2 + d], 0, 0, 0);
            } else {
#pragma unroll
                for (int d = 0; d < 2; ++d)
#pragma unroll
                    for (int ks = 0; ks < 4; ++ks) o[d] = __builtin_amdgcn_mfma_f32_32x32x16_bf16(vf[d * 4 + ks], pb[ks], o[d], 0, 0, 0);
            }
        }
        sb = sb1;
        __syncthreads();
    }
#undef ATT_LOAD
#undef ATT_WRITE
    const float linv = 1.f / xhalf_sum(lrun);
    const size_t tok = (size_t)b * SEQ + qrow0 + l31;
    if (MODE != 2) {
        bf16* orow = O + tok * 1024 + (MODE == 1 ? 512 : 0) + h * 64 + 8 * hi;
#pragma unroll
        for (int d = 0; d < NDV; ++d)
#pragma unroll
            for (int g = 0; g < 4; g += 2) {
                unsigned ax = pk2(o[d][4 * g] * linv, o[d][4 * g + 1] * linv), ay = pk2(o[d][4 * g + 2] * linv, o[d][4 * g + 3] * linv);
                unsigned bx = pk2(o[d][4 * g + 4] * linv, o[d][4 * g + 5] * linv), by = pk2(o[d][4 * g + 6] * linv, o[d][4 * g + 7] * linv);
                { auto r = __builtin_amdgcn_permlane32_swap(ax, bx, false, false); ax = r[0]; bx = r[1]; }
                { auto r = __builtin_amdgcn_permlane32_swap(ay, by, false, false); ay = r[0]; by = r[1]; }
                *(v4u*)(orow + 32 * d + 8 * g) = (v4u){ax, ay, bx, by}; }
    } else {
        LAS float* xch = (LAS float*)lds + (size_t)(w & 3) * 4096 + lane;
        if (w >= 4) {
#pragma unroll
            for (int d = 0; d < NDV; ++d)
#pragma unroll
                for (int r = 0; r < 16; ++r) xch[(d * 16 + r) * 64] = o[d][r] * linv;
        }
        __syncthreads();
        if (w < 4) {
            const float* sg = p.subln + i2 * 128 + 4 * hi; f32x4 gvv[NDV][4];
#pragma unroll
            for (int d = 0; d < NDV; ++d)
#pragma unroll
                for (int g = 0; g < 4; ++g) gvv[d][g] = *(const f32x4*)(sg + 32 * d + 8 * g);
            float ss = 0.f;
#pragma unroll
            for (int d = 0; d < NDV; ++d)
#pragma unroll
                for (int r = 0; r < 16; ++r) { const float v = o[d][r] * linv - lam * xch[(d * 16 + r) * 64]; o[d][r] = v; ss += v * v; }
            ss = xhalf_sum(ss);
            const float rs = (1.f - lam_init) / sqrtf(ss * (1.f / 128) + EPS);
            bf16* orow = O + tok * 1024 + h * 128 + 8 * hi;
#pragma unroll
            for (int d = 0; d < NDV; ++d)
#pragma unroll
                for (int g = 0; g < 4; g += 2) { const f32x4 ga = gvv[d][g], gb = gvv[d][g + 1];
                    unsigned ax = pk2(o[d][4 * g] * rs * ga.x, o[d][4 * g + 1] * rs * ga.y), ay = pk2(o[d][4 * g + 2] * rs * ga.z, o[d][4 * g + 3] * rs * ga.w);
                    unsigned bx = pk2(o[d][4 * g + 4] * rs * gb.x, o[d][4 * g + 5] * rs * gb.y), by = pk2(o[d][4 * g + 6] * rs * gb.z, o[d][4 * g + 7] * rs * gb.w);
                    { auto r = __builtin_amdgcn_permlane32_swap(ax, bx, false, false); ax = r[0]; bx = r[1]; }
                    { auto r = __builtin_amdgcn_permlane32_swap(ay, by, false, false); ay = r[0]; by = r[1]; }
                    *(v4u*)(orow + 32 * d + 8 * g) = (v4u){ax, ay, bx, by}; }
        }
        __syncthreads();
    }
}

template <int MODE>
__device__ __forceinline__ void attn_phase(const P& p, LAS unsigned char* lds, int layer, int vcu, int G, float lam_init, CvState& cs) {
    constexpr int NQB = MODE == 2 ? 32 : 16, NU = 64 * NQB;
    float lam = 0.f;
    if (MODE == 2) { const int lane = threadIdx.x & 63, i2 = layer >> 1;
        const float a1 = wave_sum(p.lq1[i2 * 64 + lane] * p.lk1[i2 * 64 + lane]), a2 = wave_sum(p.lq2[i2 * 64 + lane] * p.lk2[i2 * 64 + lane]);
        lam = expf(a1) - expf(a2) + lam_init; }
    const bool bal = (G == 256);
    const int nit = bal ? NQB / 4 : (NU - vcu + G - 1) / G;
#pragma unroll 1
    for (int i = 0; i < nit; ++i) {
        int bh, qb;
        if (bal) { const int s = vcu & 3; bh = vcu >> 2; qb = 4 * i + ((i & 1) ? 3 - s : s); } else { const int u = vcu + i * G; bh = u / NQB; qb = u % NQB; }
        attn_unit<MODE>(p, lds, layer, bh >> 3, bh & 7, qb, lam_init, lam, cs, (MODE != 2 && bal && MOE_FP8 && MOE_CONV_OVL) ? vcu : -1);
    }
}


__device__ __forceinline__ void moe_conv_rest(const P& p, LAS unsigned char* lds, int pr, int vcu, int G, CvState& cs) {
    if (G != 256 || !MOE_FP8 || !MOE_CONV_OVL) return;
    const int tid = threadIdx.x, lane = tid & 63, wave = __builtin_amdgcn_readfirstlane(tid >> 6);
    LAS float* tl = (LAS float*)(lds + WCONV_LDS_OFF);
    for (; cs.done < MOE_CONV_PER_WG; ++cs.done) { const WItem w = moe_conv_item(p, pr, vcu + 256 * cs.done); f32x4 v[8]; float g, ls; wconv_load(w, wave, lane, v, g, ls); wconv_store(w, wave, lane, v, g, ls, tl); }
}

#define XB_TMO      128
#define XB_XCNT(j)  (256  + 64 * (j))
#define XB_XSUB(j)  (1280 + 64 * (j))
#define XB_XGEN(j)  (2304 + 64 * (j))
#define XB_TOP      3328
#define XB_TOPGEN   3392
#define XCD_BAR_WORDS 3456
#define XB_SPIN_CAP (1u << 18)

__device__ __forceinline__ unsigned xb_ld(unsigned* p)              { return __hip_atomic_load(p, __ATOMIC_RELAXED, __HIP_MEMORY_SCOPE_AGENT); }
__device__ __forceinline__ unsigned xb_add(unsigned* p, unsigned v) { return __hip_atomic_fetch_add(p, v, __ATOMIC_RELAXED, __HIP_MEMORY_SCOPE_AGENT); }
__device__ __forceinline__ unsigned xb_xcc_id() { return (unsigned)__builtin_amdgcn_s_getreg((3 << 11) | 20) & 0xFu; }
#define XB_SPIN(cond, bar) do { unsigned _sp = 0; while (cond) { __builtin_amdgcn_s_sleep(1); \
    if ((++_sp & 255u) == 0u) { if (xb_ld(&(bar)[XB_TMO])) break; if (_sp > XB_SPIN_CAP) { atomicAdd(&(bar)[XB_TMO], 1u); break; } } } } while (0)

struct XcdBarrier {
    unsigned* bar; unsigned x;
    volatile LAS unsigned* st;
};

__device__ __forceinline__ XcdBarrier xcd_barrier_post(unsigned* bar, volatile LAS unsigned* st) {
    XcdBarrier b; b.bar = bar; b.x = xb_xcc_id(); b.st = st;
    if (threadIdx.x == 0) (void)xb_add(&bar[XB_XCNT(b.x)], 1u);
    return b;
}
__device__ __forceinline__ void xcd_barrier_complete(unsigned* bar, unsigned x, unsigned& nloc, unsigned& nx) {
    const unsigned G = gridDim.x * gridDim.y * gridDim.z;
    unsigned sum, cnt, mine, sp = 0u;
    for (;;) {
        sum = 0u; cnt = 0u; mine = 0u;
#pragma unroll
        for (unsigned j = 0; j < 16; ++j) { const unsigned c = xb_ld(&bar[XB_XCNT(j)]); sum += c; cnt += (c > 0u) ? 1u : 0u; mine = (j == x) ? c : mine; }
        if (sum == G) break;
        __builtin_amdgcn_s_sleep(1);
        if ((++sp & 255u) == 0u) { if (xb_ld(&bar[XB_TMO])) break; if (sp > XB_SPIN_CAP) { atomicAdd(&bar[XB_TMO], 1u); break; } }
    }
    nloc = mine > 0u ? mine : 1u; nx = cnt > 0u ? cnt : 1u;
}

__device__ __forceinline__ void xcd_barrier(const XcdBarrier& b) {
    asm volatile("s_waitcnt vmcnt(0)" ::: "memory");
    __syncthreads();
    if (threadIdx.x == 0) {
        unsigned* bar = b.bar;
        __builtin_amdgcn_s_waitcnt(0);
        unsigned nloc = b.st[0], nx = b.st[1];
        if (nloc == 0u) { xcd_barrier_complete(bar, b.x, nloc, nx); b.st[0] = nloc; b.st[1] = nx; }
        const unsigned old = xb_add(&bar[XB_XSUB(b.x)], 1u);
        const unsigned gen = old / nloc;
        if (old + 1u == (gen + 1u) * nloc) {
            __builtin_amdgcn_fence(__ATOMIC_RELEASE, "agent");
            asm volatile("s_waitcnt vmcnt(0)" ::: "memory");
            const unsigned og = xb_add(&bar[XB_TOP], 1u);
            const unsigned tg = og / nx;
            if (og + 1u == (tg + 1u) * nx) xb_add(&bar[XB_TOPGEN], 1u);
            else XB_SPIN(xb_ld(&bar[XB_TOPGEN]) == tg, bar);
            __builtin_amdgcn_fence(__ATOMIC_ACQUIRE, "agent");
            xb_add(&bar[XB_XGEN(b.x)], 1u);
            asm volatile("s_waitcnt vmcnt(0)" ::: "memory");
        } else {
            XB_SPIN(xb_ld(&bar[XB_XGEN(b.x)]) == gen, bar);
            __builtin_amdgcn_fence(__ATOMIC_ACQUIRE, "agent");
            asm volatile("s_waitcnt vmcnt(0)" ::: "memory");
        }
    }
    __syncthreads();
}


constexpr int NPHASE = 29;
struct Args { P p; int ph_lo, ph_hi; };
#define CAS __attribute__((address_space(4)))
#if defined(__HIP_DEVICE_COMPILE__)
__device__ __forceinline__ const CAS Args* kargs() { const CAS Args* q = (const CAS Args*)__builtin_amdgcn_kernarg_segment_ptr(); asm volatile("" : "+s"(q)); return q; }
#else
__device__ const Args* kargs();
#endif
#ifndef PHASE_MASK
#define PHASE_MASK 0x7fff
#endif
#define PHEN(t) (((PHASE_MASK) >> (t)) & 1)
#define IN(k) (lo <= (k) && (k) < hi)
#define SEAM(k) do { if (IN(k) && IN((k) + 1)) xcd_barrier(bar); } while (0)
#define PH_ENV const P p = kargs()->p; unsigned char* ws = p.ws; unsigned char* ar = ws + WS_AR; unsigned char* wb = ws + WS_W; \
    const bf16* HB = (const bf16*)(ws + WS_HB); float* H = (float*)(ws + WS_H); float* SSQ = (float*)(ws + WS_SSQ); \
    const int* SEG = (const int*)(ws + WS_META); (void)ar; (void)wb; (void)HB; (void)H; (void)SSQ; (void)SEG;
template <int pr>
__device__ __forceinline__ void layer_pair(LAS unsigned char* lds, const int lo, const int hi, const XcdBarrier& bar, const int bid, const int G, const int vcu) {
        const int base = 1 + 14 * pr, le = 2 * pr, lod = 2 * pr + 1;
        if (PHEN(0) && IN(base + 0)) { PH_ENV
            pg8::Gemm g{ws, (unsigned)WS_HB, (unsigned)(WS_W + WO_IN_E) + (unsigned)pr * 2048u * 1024u * 2u, 2048, 1024}; pg8::StaticOrder S; S.init(T, 2048, G, bid, nullptr);
            EpiEvenIn E{ws, lds, p.pos};
            pg8::gemm_phase(lds, g, S, E); SEAM(base + 0);
        }
        if (PHEN(1) && IN(base + 1)) { PH_ENV
            { pg8::Gemm g{ws, OA(AR_CQ), (unsigned)(WS_W + WO_UQ) + (unsigned)pr * 768u * 256u * 2u, 768, 256}; pg8::StaticOrder S; S.init(T, 768, G, bid, nullptr);
              EpiUq E{ws, p.pos}; pg8::gemm_phase(lds, g, S, E); }
            { pg8::Gemm g{ws, OA(AR_CKV), (unsigned)(WS_W + WO_UKV) + (unsigned)pr * 1024u * 256u * 2u, 1024, 256}; pg8::StaticOrder S; S.init(T, 1024, G, bid, nullptr);
              EpiUkv E{ws, lds}; pg8::gemm_phase(lds, g, S, E); }
            SEAM(base + 1);
        }
        if (PHEN(2) && IN(base + 2)) { PH_ENV CvState cs{0, 0, vcu % MOE_CONV_PERIOD}; attn_phase<0>(p, lds, le, vcu, G, 0.f, cs); attn_phase<1>(p, lds, le, vcu, G, 0.f, cs); moe_conv_rest(p, lds, pr, vcu, G, cs); SEAM(base + 2); }
        if (PHEN(3) && IN(base + 3)) { PH_ENV
            pg8::Gemm g{ws, OA(AR_MIX), (unsigned)(WS_W + WO_OUT_E) + (unsigned)pr * 1024u * 1024u * 2u, 1024, 1024}; pg8::StaticOrder S; S.init(T, 1024, G, bid, nullptr);
            EpiRes<((FFN8_GU >> pr) & 1) != 0> E{ws, pr == 0 ? p.x : (const float*)H, 1.f}; pg8::gemm_phase(lds, g, S, E); SEAM(base + 3);
        }
        if (PHEN(4) && IN(base + 4)) { PH_ENV
            constexpr bool A8 = ((FFN8_DN >> pr) & 1) != 0;
            if constexpr (((FFN8_GU >> pr) & 1) != 0) {
                pg8::Gemm g{ws, OA(AR_HB8), (unsigned)(WS_W + WO_GU_D) + (unsigned)pr * 5632u * 1024u * 2u, 5632, 1024}; pg8::StaticOrder S; S.init(T, 5632, G, bid, nullptr);
                EpiSwigluX<true, true, A8> E{ws, OA(AR_ACT), FFD}; pg8::gemm_phase<EpiSwigluX<true, true, A8>, pg8::StaticOrder, true>(lds, g, S, E);
            } else {
                pg8::Gemm g{ws, (unsigned)WS_HB, (unsigned)(WS_W + WO_GU_D) + (unsigned)pr * 5632u * 1024u * 2u, 5632, 1024}; pg8::StaticOrder S; S.init(T, 5632, G, bid, nullptr);
                EpiSwigluX<true, false, A8> E{ws, OA(AR_ACT), FFD}; pg8::gemm_phase(lds, g, S, E);
            }
            SEAM(base + 4);
        }
        if (PHEN(5) && IN(base + 5)) { PH_ENV
            if constexpr (((FFN8_DN >> pr) & 1) != 0) {
                pg8::Gemm g{ws, OA(AR_ACT), (unsigned)(WS_W + WO_DN_D) + (unsigned)pr * 1024u * 2816u * 2u, 1024, 2816}; pg8::StaticOrder S; S.init(T, 1024, G, bid, nullptr);
                EpiRes<false> E{ws, (const float*)H, 1.f / (FP8_AS * FP8_WS_DN)}; pg8::gemm_phase<EpiRes<false>, pg8::StaticOrder, true>(lds, g, S, E);
            } else {
                pg8::Gemm g{ws, OA(AR_ACT), (unsigned)(WS_W + WO_DN_D) + (unsigned)pr * 1024u * 2816u * 2u, 1024, 2816}; pg8::StaticOrder S; S.init(T, 1024, G, bid, nullptr);
                EpiRes<false> E{ws, (const float*)H, 1.f}; pg8::gemm_phase(lds, g, S, E);
            }
            SEAM(base + 5);
        }
        if (PHEN(6) && IN(base + 6)) { PH_ENV
            pg8::Gemm g{ws, (unsigned)WS_HB, (unsigned)(WS_W + WO_IN_O) + (unsigned)pr * 3072u * 1024u * 2u, 3072, 1024}; pg8::StaticOrder S; S.init(T, 3072, G, bid, nullptr);
            EpiOddIn E{ws, lds, p.pos}; pg8::gemm_phase(lds, g, S, E); SEAM(base + 6);
        }
        if (PHEN(7) && IN(base + 7)) { PH_ENV CvState cs{0, 0, 0}; attn_phase<2>(p, lds, lod, vcu, G, pr == 0 ? 0.35550906759096934f : 0.5560582041556406f, cs); SEAM(base + 7); }
        if (PHEN(8) && IN(base + 8)) { PH_ENV
            pg8::Gemm g{ws, OA(AR_MIX), (unsigned)(WS_W + WO_OUT_O) + (unsigned)pr * 1024u * 1024u * 2u, 1024, 1024}; pg8::StaticOrder S; S.init(T, 1024, G, bid, nullptr);
            EpiRes<false, false> E{ws, (const float*)H, 1.f}; pg8::gemm_phase(lds, g, S, E); SEAM(base + 8);
        }
        if (PHEN(9) && IN(base + 9)) { PH_ENV ph_route(p, lod, bid, G, (LAS int*)lds); SEAM(base + 9); }
        if (PHEN(10) && IN(base + 10)) { PH_ENV ph_gather(p, bid, G, (LAS int*)lds); SEAM(base + 10); }
        if (PHEN(11) && IN(base + 11)) { PH_ENV
#if MOE_FP8
            pg8::Gemm g{ws, OA(AR_XG), (unsigned)(WS_W + WO_GU_M) + (unsigned)pr * 8u * 7168u * 1024u, 7168, 1024}; pg8::StaticOrder S; S.init(0, 7168, G, bid, SEG);
            EpiSwigluFp8<false> E{ws, OA(AR_ACTM), FFE}; pg8::gemm_phase<EpiSwigluFp8<false>, pg8::StaticOrder, true>(lds, g, S, E); SEAM(base + 11);
#else
            pg8::Gemm g{ws, OA(AR_XG), (unsigned)(WS_W + WO_GU_M) + (unsigned)pr * 8u * 7168u * 1024u * 2u, 7168, 1024}; pg8::StaticOrder S; S.init(0, 7168, G, bid, SEG);
            EpiSwiglu<false> E{ws, OA(AR_ACTM), FFE}; pg8::gemm_phase(lds, g, S, E); SEAM(base + 11);
#endif
        }
        if (PHEN(12) && IN(base + 12)) { PH_ENV
#if MOE_FP8
            pg8::Gemm g{ws, OA(AR_ACTM), (unsigned)(WS_W + WO_DN_M) + (unsigned)pr * 8u * 1024u * 3584u, 1024, 3584}; pg8::StaticOrder S; S.init(0, 1024, G, bid, SEG);
            EpiMoeDown E{ws, 1.f / (FP8_AS * FP8_WS_DN)}; pg8::gemm_phase<EpiMoeDown, pg8::StaticOrder, true>(lds, g, S, E); SEAM(base + 12);
#else
            pg8::Gemm g{ws, OA(AR_ACTM), (unsigned)(WS_W + WO_DN_M) + (unsigned)pr * 8u * 1024u * 3584u * 2u, 1024, 3584}; pg8::StaticOrder S; S.init(0, 1024, G, bid, SEG);
            EpiMoeDown E{ws, 1.f}; pg8::gemm_phase(lds, g, S, E); SEAM(base + 12);
#endif
        }
        if (PHEN(13) && IN(base + 13)) { PH_ENV ph_combine(p, pr == 1, bid, G); SEAM(base + 13); }
}
__global__ void __launch_bounds__(NWAVES * 64, 2) mega(Args args) {
    extern __shared__ __attribute__((aligned(16))) unsigned char lds_raw[];
    LAS unsigned char* lds = (LAS unsigned char*)lds_raw;
    const int tid = threadIdx.x, G = gridDim.x, bid = blockIdx.x;
    const int vcu = (G % 8 == 0) ? (bid % 8) * (G / 8) + bid / 8 : bid;
    volatile LAS unsigned* MISC = (volatile LAS unsigned*)(lds + LDSCTL_OFF);
    for (int u = tid; u < 128; u += NWAVES * 64) MISC[u] = 0u;
    __syncthreads();
    const int lo = kargs()->ph_lo, hi = kargs()->ph_hi;
    unsigned* const barw = (unsigned*)(kargs()->p.ws + WS_CTL) + CW_BAR;
    XcdBarrier bar; bar.bar = barw; bar.x = 0; bar.st = nullptr;
    if (hi - lo > 1) bar = xcd_barrier_post(barw, MISC + 8);

    if (PHEN(14) && IN(0)) { PH_ENV ph_wconv(p, lds, bid, G); ph_prologue(p, bid, G); SEAM(0); }
    layer_pair<0>(lds, lo, hi, bar, bid, G, vcu);
    layer_pair<1>(lds, lo, hi, bar, bid, G, vcu);
#undef IN
#undef SEAM
#undef PH_ENV
}


extern "C" void kernel_launch(void* const* d_in, const int* in_sizes, int n_in, void* d_out, int out_size, void* d_ws, size_t ws_size, hipStream_t stream) {
    static int grid = 0;
    if (grid == 0) {
        if (n_in != 24 || ws_size < WS_TMP) fprintf(stderr, "kernel_launch: unexpected n_in %d or ws_size %zu (need %zu)\n", n_in, ws_size, (size_t)WS_TMP);
        int dev = 0, cus = 0, per_cu = 0;
        if (hipGetDevice(&dev) != hipSuccess || hipDeviceGetAttribute(&cus, hipDeviceAttributeMultiprocessorCount, dev) != hipSuccess) { fprintf(stderr, "kernel_launch: device query failed\n"); grid = -1; return; }
        if (hipFuncSetAttribute((const void*)mega, hipFuncAttributeMaxDynamicSharedMemorySize, LDS_BYTES) != hipSuccess) { fprintf(stderr, "kernel_launch: hipFuncSetAttribute failed\n"); grid = -1; return; }
        if (hipOccupancyMaxActiveBlocksPerMultiprocessor(&per_cu, (const void*)mega, NWAVES * 64, LDS_BYTES) != hipSuccess || per_cu < 1) fprintf(stderr, "kernel_launch: occupancy query reports %d blocks per CU\n", per_cu);
        (void)hipGetLastError();
        grid = cus;
    }
    if (grid < 0) return;
    Args a{};
    P& p = a.p;
    p.x = (const float*)d_in[0]; p.pos = (const int*)d_in[1]; p.mix_g = (const float*)d_in[2]; p.ffn_g = (const float*)d_in[3]; p.w_in_e = (const float*)d_in[4]; p.relb = (const float*)d_in[5];
    p.qn_g = (const float*)d_in[6]; p.w_uq = (const float*)d_in[7]; p.kvn_g = (const float*)d_in[8]; p.w_ukv = (const float*)d_in[9]; p.w_out_e = (const float*)d_in[10]; p.w_in_o = (const float*)d_in[11];
    p.lq1 = (const float*)d_in[12]; p.lk1 = (const float*)d_in[13]; p.lq2 = (const float*)d_in[14]; p.lk2 = (const float*)d_in[15]; p.subln = (const float*)d_in[16]; p.w_out_o = (const float*)d_in[17];
    p.w_gu_d = (const float*)d_in[18]; p.w_dn_d = (const float*)d_in[19]; p.w_rt = (const float*)d_in[20]; p.w_gu_m = (const float*)d_in[21]; p.w_dn_m = (const float*)d_in[22]; p.fin_g = (const float*)d_in[23];
    p.out = (float*)d_out; p.ws = (unsigned char*)d_ws;
    (void)hipMemsetAsync((unsigned char*)d_ws + WS_CTL, 0, 65536, stream);
#if ONE_LAUNCH
    a.ph_lo = 0; a.ph_hi = NPHASE;
    hipLaunchKernelGGL(mega, dim3(grid), dim3(NWAVES * 64), LDS_BYTES, stream, a);
#else
    for (int k = 0; k < NPHASE; ++k) {
        a.ph_lo = k; a.ph_hi = k + 1;
        hipLaunchKernelGGL(mega, dim3(grid), dim3(NWAVES * 64), LDS_BYTES, stream, a);
#if defined(DUP_MASK)
        if ((DUP_MASK >> (k == 0 ? 14 : (k - 1) % 14)) & 1) for (int r = 0; r < DUP_N; ++r) hipLaunchKernelGGL(mega, dim3(grid), dim3(NWAVES * 64), LDS_BYTES, stream, a);
#endif
    }
#endif
    const hipError_t le = hipPeekAtLastError();
    if (le != hipSuccess) fprintf(stderr, "kernel_launch: launch failed: %s\n", hipGetErrorName(le));
}
```

```cpp
#include <hip/hip_runtime.h>
#include <stdint.h>
#include <stdio.h>
#include <cmath>
#define MOE_CONV_OVL 0
#ifndef ONE_LAUNCH
#define ONE_LAUNCH 1
#endif

constexpr int NB = 8, SEQ = 4096, T = NB * SEQ, D = 1024;
constexpr float EPS = 1e-6f;
constexpr float LOG2E = 1.4426950408889634f;
constexpr int FFD = 2816, FFE = 3584, NEXP = 8;
constexpr int NSLOT = 2 * T + NEXP * 256;
constexpr int EIN = 1952;
constexpr int NCHUNK_R = 256, RCH = 128;

typedef unsigned short bf16;
typedef unsigned v4u __attribute__((ext_vector_type(4)));
typedef unsigned v2u __attribute__((ext_vector_type(2)));
typedef float f32x4 __attribute__((ext_vector_type(4)));

constexpr size_t MiB = 1u << 20;
constexpr size_t WS_CTL = 0;
constexpr size_t WS_META = 1 * MiB;
constexpr size_t WS_SSQ = 14 * MiB;
constexpr size_t WS_SSQQ = 16 * MiB;
constexpr size_t WS_SSQKV = 16 * MiB + 512 * 1024;
constexpr size_t WS_TOPE = 17 * MiB;
constexpr size_t WS_TOPG = WS_TOPE + 256 * 1024;
constexpr size_t WS_LRANK = WS_TOPG + 256 * 1024;
constexpr size_t WS_SLOT = WS_LRANK + 256 * 1024;
constexpr size_t WS_TOKI = 18 * MiB;
constexpr size_t WS_GATE = WS_TOKI + 512 * 1024;
constexpr size_t WS_H = 20 * MiB;
constexpr size_t WS_HB = 148 * MiB;
constexpr size_t WS_W = 212 * MiB;
constexpr size_t WS_AR = 612 * MiB;
constexpr size_t WS_TMP = 1340 * MiB;
constexpr size_t WS_END = 1724 * MiB;
constexpr size_t AR_QA = 0, AR_KA = 32 * MiB, AR_VAT = 64 * MiB, AR_CQ = 96 * MiB, AR_CKV = 112 * MiB  , AR_QB = 128 * MiB, AR_KB = 176 * MiB, AR_VBT = 224 * MiB, AR_MIX = 256 * MiB;
constexpr size_t AR_ACT = 0;
constexpr size_t AR_HB8 = 192 * MiB;
constexpr size_t AR_QC = 0, AR_KC = 64 * MiB, AR_VCT = 128 * MiB;
constexpr size_t AR_XG = 0, AR_HN = 68 * MiB  , AR_ACTM = 136 * MiB, AR_Y = 598 * MiB;

typedef float f32x2_t __attribute__((ext_vector_type(2))); typedef __bf16 bf16x2_t __attribute__((ext_vector_type(2)));
__device__ __forceinline__ unsigned pk2(float lo, float hi) { const f32x2_t v = {lo, hi}; const bf16x2_t b = __builtin_convertvector(v, bf16x2_t); return __builtin_bit_cast(unsigned, b); }
__device__ __forceinline__ unsigned f2bf(float f) { return pk2(f, 0.f) & 0xffffu; }
__device__ __forceinline__ float bf2f(unsigned b) { return __builtin_bit_cast(float, b << 16); }
__device__ __forceinline__ float wave_sum(float v) {
#pragma unroll
    for (int o = 1; o < 64; o <<= 1) v += __shfl_xor(v, o);
    return v;
}
__device__ __forceinline__ float wave_max(float v) {
#pragma unroll
    for (int o = 1; o < 64; o <<= 1) v = fmaxf(v, __shfl_xor(v, o));
    return v;
}
__host__ __device__ __forceinline__ int permk(int s) { return (s & ~12) | ((s & 4) << 1) | ((s & 8) >> 1); }

struct P {
    const float* x; const int* pos; const float* mix_g; const float* ffn_g; const float* w_in_e; const float* relb; const float* qn_g; const float* w_uq;
    const float* kvn_g; const float* w_ukv; const float* w_out_e; const float* w_in_o; const float* lq1; const float* lk1; const float* lq2; const float* lk2;
    const float* subln; const float* w_out_o; const float* w_gu_d; const float* w_dn_d; const float* w_rt; const float* w_gu_m; const float* w_dn_m; const float* fin_g;
    float* out; unsigned char* ws;
    int layer, last;
};

#ifndef MOE_FP8
#define MOE_FP8 1
#endif
#ifndef H_BF16
#define H_BF16 1
#endif
#ifndef FFN8_GU
#define FFN8_GU 2
#endif
#ifndef FFN8_DN
#define FFN8_DN 2
#endif
#ifndef FFN_FP8
#define FFN_FP8 0
#endif
__device__ __forceinline__ unsigned pk4_fp8x(float a, float b, float c, float d) {
    int w = __builtin_amdgcn_cvt_pk_fp8_f32(__builtin_amdgcn_fmed3f(a, -448.f, 448.f), __builtin_amdgcn_fmed3f(b, -448.f, 448.f), 0, false);
    w = __builtin_amdgcn_cvt_pk_fp8_f32(__builtin_amdgcn_fmed3f(c, -448.f, 448.f), __builtin_amdgcn_fmed3f(d, -448.f, 448.f), w, true); return (unsigned)w; }
__device__ __forceinline__ void ph_prologue(const P& p, int bid, int nblk) {
    const int tid = threadIdx.x, nth = blockDim.x, lane = tid & 63, wave = tid >> 6, nw = nth >> 6;
    bf16* HB = (bf16*)(p.ws + WS_HB); float* SSQ = (float*)(p.ws + WS_SSQ);
    const int stride = nblk * nw; int row = bid * nw + wave;
    f32x4 v[4];
    if (row < T) { const f32x4* xr = (const f32x4*)(p.x + (size_t)row * D) + lane;
#pragma unroll
        for (int j = 0; j < 4; ++j) v[j] = xr[64 * j]; }
    for (; row < T; row += stride) {
        f32x4 vn[4];
        { const int rn = row + stride < T ? row + stride : row; const f32x4* xr = (const f32x4*)(p.x + (size_t)rn * D) + lane;
#pragma unroll
          for (int j = 0; j < 4; ++j) vn[j] = xr[64 * j]; }
        float s = 0.f;
#pragma unroll
        for (int j = 0; j < 4; ++j) s += v[j].x * v[j].x + v[j].y * v[j].y + v[j].z * v[j].z + v[j].w * v[j].w;
        s = wave_sum(s);
        v2u* o = (v2u*)(HB + (size_t)row * D) + lane;
#pragma unroll
        for (int j = 0; j < 4; ++j) { v2u w; w.x = pk2(v[j].x, v[j].y); w.y = pk2(v[j].z, v[j].w); o[64 * j] = w; }
        if (lane < 16) SSQ[row * 16 + lane] = lane == 0 ? s : 0.f;
#pragma unroll
        for (int j = 0; j < 4; ++j) v[j] = vn[j];
    }
}

template <class IP> __device__ __forceinline__ void ph_route(const P& p, int layer, int bid, int nblk, IP se  ) {
    const int tid = threadIdx.x, nth = blockDim.x, lane = tid & 63, wave = tid >> 6, nw = nth >> 6;
    const int i2 = layer >> 1;
    const float* H = (const float*)(p.ws + WS_H); bf16* HB = (bf16*)(p.ws + WS_HB); (void)H;
    bf16* HNo = H_BF16 ? (bf16*)(p.ws + WS_AR + AR_HN) : HB;
    const float* g = p.ffn_g + layer * D; const float* wr = p.w_rt + (size_t)i2 * D * 8;
    int* TOPE = (int*)(p.ws + WS_TOPE); float* TOPG = (float*)(p.ws + WS_TOPG); int* LRANK = (int*)(p.ws + WS_LRANK); int* CNT = (int*)(p.ws + WS_META + 4096);
    float wg[16][8];
#pragma unroll
    for (int j = 0; j < 4; ++j)
#pragma unroll
        for (int q = 0; q < 4; ++q) { const int k = lane * 4 + 256 * j + q; const float gk = g[k];
            const f32x4 w0 = *(const f32x4*)(wr + (size_t)k * 8), w1 = *(const f32x4*)(wr + (size_t)k * 8 + 4);
            wg[4 * j + q][0] = w0.x * gk; wg[4 * j + q][1] = w0.y * gk; wg[4 * j + q][2] = w0.z * gk; wg[4 * j + q][3] = w0.w * gk;
            wg[4 * j + q][4] = w1.x * gk; wg[4 * j + q][5] = w1.y * gk; wg[4 * j + q][6] = w1.z * gk; wg[4 * j + q][7] = w1.w * gk; }
    const bool b5 = lane & 32, b4 = lane & 16, b3 = lane & 8;
    for (int ch = bid; ch < NCHUNK_R; ch += nblk) {
#if H_BF16
#define RT_LOAD(V, tk) do { const v2u* hr_ = (const v2u*)(HB + (size_t)(tk) * D) + lane; _Pragma("unroll") for (int j = 0; j < 4; ++j) { const v2u t_ = hr_[64 * j]; \
        V[j].x = bf2f(t_.x & 0xffffu); V[j].y = bf2f(t_.x >> 16); V[j].z = bf2f(t_.y & 0xffffu); V[j].w = bf2f(t_.y >> 16); } } while (0)
#else
#define RT_LOAD(V, tk) do { const f32x4* hr_ = (const f32x4*)(H + (size_t)(tk) * D) + lane; _Pragma("unroll") for (int j = 0; j < 4; ++j) V[j] = hr_[64 * j]; } while (0)
#endif
        f32x4 v[4];
        RT_LOAD(v, ch * RCH + wave);
        for (int i = wave; i < RCH; i += nw) {
            const int tok = ch * RCH + i;
            f32x4 vn[4];
            { const int tn = (i + nw < RCH) ? tok + nw : tok; RT_LOAD(vn, tn); }
            float s = 0.f;
#pragma unroll
            for (int j = 0; j < 4; ++j) s += v[j].x * v[j].x + v[j].y * v[j].y + v[j].z * v[j].z + v[j].w * v[j].w;
            s = wave_sum(s);
            const float rstd = 1.0f / sqrtf(s * (1.f / D) + EPS);
            float lg[8];
#pragma unroll
            for (int e = 0; e < 8; ++e) lg[e] = 0.f;
            v2u* o = (v2u*)(HNo + (size_t)tok * D) + lane;
#pragma unroll
            for (int j = 0; j < 4; ++j) {
                const float hn[4] = {v[j].x * rstd, v[j].y * rstd, v[j].z * rstd, v[j].w * rstd};
                v2u w; w.x = pk2(hn[0], hn[1]); w.y = pk2(hn[2], hn[3]); o[64 * j] = w;
#pragma unroll
                for (int q = 0; q < 4; ++q)
#pragma unroll
                    for (int e = 0; e < 8; ++e) lg[e] += hn[q] * wg[4 * j + q][e];
            }
            float a4[4], a2[2];
#pragma unroll
            for (int e = 0; e < 4; ++e) { const float keep = b5 ? lg[e + 4] : lg[e], send = b5 ? lg[e] : lg[e + 4]; a4[e] = keep + __shfl_xor(send, 32); }
#pragma unroll
            for (int e = 0; e < 2; ++e) { const float keep = b4 ? a4[e + 2] : a4[e], send = b4 ? a4[e] : a4[e + 2]; a2[e] = keep + __shfl_xor(send, 16); }
            float c1; { const float keep = b3 ? a2[1] : a2[0], send = b3 ? a2[0] : a2[1]; c1 = keep + __shfl_xor(send, 8); }
            c1 += __shfl_xor(c1, 4); c1 += __shfl_xor(c1, 2); c1 += __shfl_xor(c1, 1);
            float lt[8];
#pragma unroll
            for (int e = 0; e < 8; ++e) lt[e] = __uint_as_float(__builtin_amdgcn_readlane(__float_as_uint(c1), 32 * (e >> 2) + 16 * ((e >> 1) & 1) + 8 * (e & 1)));
            int e1 = 0; float v1 = lt[0];
#pragma unroll
            for (int e = 1; e < 8; ++e) if (lt[e] > v1) { v1 = lt[e]; e1 = e; }
            int e2 = -1; float v2 = -INFINITY;
#pragma unroll
            for (int e = 0; e < 8; ++e) if (e != e1 && lt[e] > v2) { v2 = lt[e]; e2 = e; }
            const float g1 = 1.f / (1.f + expf(v2 - v1));
            if (lane == 0) { se[2 * i] = e1; se[2 * i + 1] = e2; TOPE[tok * 2] = e1; TOPE[tok * 2 + 1] = e2; TOPG[tok * 2] = g1; TOPG[tok * 2 + 1] = 1.f - g1; }
#pragma unroll
            for (int j = 0; j < 4; ++j) v[j] = vn[j];
        }
        __syncthreads();
        IP wcnt = se + 256;
        int myr = 0, mye = 0;
        if (wave < 4) { mye = se[64 * wave + lane];
#pragma unroll
            for (int e = 0; e < 8; ++e) { const unsigned long long m = __ballot(mye == e); if (mye == e) myr = __popcll(m & ((1ull << lane) - 1ull)); if (lane == 0) wcnt[wave * 8 + e] = __popcll(m); } }
        __syncthreads();
        if (wave < 4) { for (int w2 = 0; w2 < wave; ++w2) myr += wcnt[w2 * 8 + mye]; LRANK[ch * 256 + 64 * wave + lane] = myr; }
        if (tid < 8) CNT[ch * 8 + tid] = wcnt[tid] + wcnt[8 + tid] + wcnt[16 + tid] + wcnt[24 + tid];
        __syncthreads();
    }
}

template <class IP> __device__ __forceinline__ void ph_gather(const P& p, int bid, int nblk, IP base  ) {
    const int tid = threadIdx.x, nth = blockDim.x, lane = tid & 63, wave = tid >> 6, nw = nth >> 6;
    const int* CNT = (const int*)(p.ws + WS_META + 4096); int* META = (int*)(p.ws + WS_META);
    IP seg = base + 2048; IP tot = base + 2048 + 16;
    for (int i = tid; i < 2048; i += nth) base[i] = CNT[i];
    __syncthreads();
    if (wave < 8) {
        const int e = wave; int c[4], t = 0;
#pragma unroll
        for (int i = 0; i < 4; ++i) { c[i] = base[(4 * lane + i) * 8 + e]; t += c[i]; }
        int inc = t;
#pragma unroll
        for (int d = 1; d < 64; d <<= 1) { const int u = __shfl_up(inc, d); if (lane >= d) inc += u; }
        int run = inc - t;
#pragma unroll
        for (int i = 0; i < 4; ++i) { base[(4 * lane + i) * 8 + e] = run; run += c[i]; }
        if (lane == 63) tot[e] = inc;
    }
    __syncthreads();
    if (tid == 0) { int s = 0; for (int e = 0; e < 8; ++e) { seg[e] = s; s += (tot[e] + 255) & ~255; } seg[8] = s; }
    __syncthreads();
    if (bid == 0 && tid < 9) META[tid] = seg[tid];
    if (bid == 0 && tid < 8) META[16 + tid] = tot[tid];
    const int* TOPE = (const int*)(p.ws + WS_TOPE); const float* TOPG = (const float*)(p.ws + WS_TOPG); const int* LRANK = (const int*)(p.ws + WS_LRANK);
    int* SLOT = (int*)(p.ws + WS_SLOT); int* TOKI = (int*)(p.ws + WS_TOKI); float* GATE = (float*)(p.ws + WS_GATE);
    const bf16* HB = H_BF16 ? (const bf16*)(p.ws + WS_AR + AR_HN) : (const bf16*)(p.ws + WS_HB); bf16* XG = (bf16*)(p.ws + WS_AR + AR_XG);
    IP lslot = base + 2048 + 32;
    for (int ch = bid; ch < NCHUNK_R; ch += nblk) {
        if (tid < 256) { const int ent = ch * 256 + tid; const int e = TOPE[ent]; const int slot = seg[e] + base[ch * 8 + e] + LRANK[ent];
            SLOT[ent] = slot; TOKI[slot] = ent; GATE[slot] = TOPG[ent]; lslot[tid] = slot; }
        __syncthreads();
#pragma unroll 4
        for (int j = wave; j < 256; j += nw) {
            const int tok = (ch * 256 + j) >> 1; const int slot = lslot[j];
#if MOE_FP8
            const v4u* src = (const v4u*)(HB + (size_t)tok * D) + 2 * lane; const v4u a = src[0], b = src[1];
            v4u o;
            o.x = pk4_fp8x(bf2f(a.x & 0xffffu), bf2f(a.x >> 16), bf2f(a.y & 0xffffu), bf2f(a.y >> 16)); o.y = pk4_fp8x(bf2f(a.z & 0xffffu), bf2f(a.z >> 16), bf2f(a.w & 0xffffu), bf2f(a.w >> 16));
            o.z = pk4_fp8x(bf2f(b.x & 0xffffu), bf2f(b.x >> 16), bf2f(b.y & 0xffffu), bf2f(b.y >> 16)); o.w = pk4_fp8x(bf2f(b.z & 0xffffu), bf2f(b.z >> 16), bf2f(b.w & 0xffffu), bf2f(b.w >> 16));
            *((v4u*)((unsigned char*)XG + (size_t)slot * D) + lane) = o;
#else
            const v4u* src = (const v4u*)(HB + (size_t)tok * D) + lane; v4u* dst = (v4u*)(XG + (size_t)slot * D) + lane;
            dst[0] = src[0]; dst[64] = src[64];
#endif
        }
        __syncthreads();
    }
    for (int e = 0; e < 8; ++e) {
        const int s0 = seg[e] + tot[e], npad = seg[e + 1] - s0;
        for (int q = bid * nw + wave; q < npad; q += nblk * nw) {
            const int slot = s0 + q;
            if (lane == 0) { TOKI[slot] = -1; GATE[slot] = 0.f; }
            const v4u z = {0u, 0u, 0u, 0u};
#if MOE_FP8
            *((v4u*)((unsigned char*)XG + (size_t)slot * D) + lane) = z;
#else
            v4u* dst = (v4u*)(XG + (size_t)slot * D) + lane; dst[0] = z; dst[64] = z;
#endif
        }
    }
}

__device__ __forceinline__ void ph_combine(const P& p, int last, int bid, int nblk) {
    const int tid = threadIdx.x, nth = blockDim.x, lane = tid & 63, wave = tid >> 6, nw = nth >> 6;
    float* H = (float*)(p.ws + WS_H); bf16* HB = (bf16*)(p.ws + WS_HB); float* SSQ = (float*)(p.ws + WS_SSQ);
    const bf16* Y = (const bf16*)(p.ws + WS_AR + AR_Y);
    const int stride = nblk * nw; int row = bid * nw + wave;
    f32x4 v[4]; v2u ya[4], yb[4];
#if H_BF16
#define CMB_LOAD(r, V, A, B) do { const v2u* hr_ = (const v2u*)(HB + (size_t)(r) * D) + lane; const v2u* y0_ = (const v2u*)(Y + (size_t)(r) * D) + lane; const v2u* y1_ = (const v2u*)(Y + (size_t)(T + (r)) * D) + lane; \
        _Pragma("unroll") for (int j = 0; j < 4; ++j) { const v2u t_ = hr_[64 * j]; V[j].x = bf2f(t_.x & 0xffffu); V[j].y = bf2f(t_.x >> 16); V[j].z = bf2f(t_.y & 0xffffu); V[j].w = bf2f(t_.y >> 16); A[j] = y0_[64 * j]; B[j] = y1_[64 * j]; } } while (0)
#else
#define CMB_LOAD(r, V, A, B) do { const f32x4* hr_ = (const f32x4*)(H + (size_t)(r) * D) + lane; const v2u* y0_ = (const v2u*)(Y + (size_t)(r) * D) + lane; const v2u* y1_ = (const v2u*)(Y + (size_t)(T + (r)) * D) + lane; \
        _Pragma("unroll") for (int j = 0; j < 4; ++j) { V[j] = hr_[64 * j]; A[j] = y0_[64 * j]; B[j] = y1_[64 * j]; } } while (0)
#endif
    if (row < T) CMB_LOAD(row, v, ya, yb);
    for (; row < T; row += stride) {
        f32x4 vn[4]; v2u yan[4], ybn[4];
        { const int rn = row + stride < T ? row + stride : row; CMB_LOAD(rn, vn, yan, ybn); }
        float s = 0.f;
#pragma unroll
        for (int j = 0; j < 4; ++j) {
            const v2u a = ya[j], b = yb[j];
            v[j].x += bf2f(a.x & 0xffffu) + bf2f(b.x & 0xffffu); v[j].y += bf2f(a.x >> 16) + bf2f(b.x >> 16);
            v[j].z += bf2f(a.y & 0xffffu) + bf2f(b.y & 0xffffu); v[j].w += bf2f(a.y >> 16) + bf2f(b.y >> 16);
            s += v[j].x * v[j].x + v[j].y * v[j].y + v[j].z * v[j].z + v[j].w * v[j].w;
        }
        s = wave_sum(s);
        if (last) {
            const float rstd = 1.0f / sqrtf(s * (1.f / D) + EPS);
            f32x4* orow = (f32x4*)(p.out + (size_t)row * D) + lane;
#pragma unroll
            for (int j = 0; j < 4; ++j) { const f32x4 gv = *((const f32x4*)p.fin_g + lane + 64 * j); f32x4 o; o.x = v[j].x * rstd * gv.x; o.y = v[j].y * rstd * gv.y; o.z = v[j].z * rstd * gv.z; o.w = v[j].w * rstd * gv.w; orow[64 * j] = o; }
        } else {
            f32x4* hr = (f32x4*)(H + (size_t)row * D) + lane; v2u* o = (v2u*)(HB + (size_t)row * D) + lane;
#pragma unroll
            for (int j = 0; j < 4; ++j) { if (!H_BF16) hr[64 * j] = v[j]; v2u w; w.x = pk2(v[j].x, v[j].y); w.y = pk2(v[j].z, v[j].w); o[64 * j] = w; }
            if (lane < 16) SSQ[row * 16 + lane] = lane == 0 ? s : 0.f;
        }
#pragma unroll
        for (int j = 0; j < 4; ++j) { v[j] = vn[j]; ya[j] = yan[j]; yb[j] = ybn[j]; }
    }
#undef CMB_LOAD
}


#define GAS __attribute__((address_space(1)))
#define LAS __attribute__((address_space(3)))
typedef short bf16x8 __attribute__((ext_vector_type(8)));
typedef float f32x16 __attribute__((ext_vector_type(16)));
typedef float f32x2 __attribute__((ext_vector_type(2)));
typedef GAS unsigned gu32;
#define RLX_AGENT __ATOMIC_RELAXED, __HIP_MEMORY_SCOPE_AGENT
#define LDS_WAIT() asm volatile("s_waitcnt lgkmcnt(0)" ::: "memory")

constexpr int NWAVES = 8;
constexpr int LDS_BYTES = 147456;
constexpr int LDSCTL_OFF = LDS_BYTES - 512;
constexpr int CW_BAR = 4096;

constexpr size_t WO_IN_E = 0, WO_UQ = 8 * MiB, WO_UKV = 9 * MiB, WO_OUT_E = 10 * MiB, WO_IN_O = 14 * MiB, WO_OUT_O = 26 * MiB, WO_GU_D = 30 * MiB, WO_DN_D = 52 * MiB, WO_GU_M = 63 * MiB, WO_DN_M = 287 * MiB;
enum { WK_IN_E = 0, WK_UQ, WK_UKV, WK_OUT_E, WK_IN_O, WK_OUT_O, WK_GU_D, WK_DN_D, WK_GU_M, WK_DN_M, WK_N };
struct WKind { int K, NS, ND, KD, ninst; size_t off; };
__device__ __host__ constexpr WKind wkind(int k) {
    return k == WK_IN_E ? WKind{1024, 1952, 2048, 1024, 2, WO_IN_E} : k == WK_UQ ? WKind{256, 768, 768, 256, 2, WO_UQ} : k == WK_UKV ? WKind{128, 1024, 1024, 256, 2, WO_UKV}
         : k == WK_OUT_E ? WKind{1024, 1024, 1024, 1024, 2, WO_OUT_E} : k == WK_IN_O ? WKind{1024, 3072, 3072, 1024, 2, WO_IN_O} : k == WK_OUT_O ? WKind{1024, 1024, 1024, 1024, 2, WO_OUT_O}
         : k == WK_GU_D ? WKind{1024, 5632, 5632, 1024, 2, WO_GU_D} : k == WK_DN_D ? WKind{2816, 1024, 1024, 2816, 2, WO_DN_D} : k == WK_GU_M ? WKind{1024, 7168, 7168, 1024, 16, WO_GU_M}
         : WKind{3584, 1024, 1024, 3584, 16, WO_DN_M};
}
__device__ __host__ constexpr long witems(int k) { return (long)wkind(k).ninst * (wkind(k).KD / 64) * (wkind(k).ND / 256); }
__device__ __forceinline__ int srccol(int kind, int n) {
    switch (kind) {
    case WK_IN_E: return n < EIN ? n : -1;
    case WK_UQ: { if (n < 512) return (n >> 6) * 96 + (n & 63); const int t = n - 512, half = t >> 7, tt = t & 127; return (tt >> 4) * 96 + 64 + 16 * half + (tt & 15); }
    case WK_IN_O: { if (n >= 2048) return n; const int pn = n >> 8, t = n & 255, half = t >> 7, tt = t & 127; return (pn < 4 ? 0 : 1024) + 64 * (4 * (pn & 3) + (tt >> 5)) + 32 * half + (tt & 31); }
    case WK_GU_D: { const int pn = n >> 8, t = n & 255; return t < 128 ? 128 * pn + t : FFD + 128 * pn + t - 128; }
    case WK_GU_M: { const int pn = n >> 8, t = n & 255; return t < 128 ? 128 * pn + t : FFE + 128 * pn + t - 128; }
    default: return n;
    }
}
#ifndef MOE_FP8
#define MOE_FP8 1
#endif
struct WItem { const float* W; const float* gain; unsigned char* dst; int K, NS, KD, kind, k0, n0; float wscale; int fp8; };
__device__ __forceinline__ WItem wconv_decode(const P& p, long it) {
    long r = it; int kind = 0;
#pragma unroll
    for (int k = 0; k < WK_N - 1; ++k) { if (kind == k && r >= witems(k)) { r -= witems(k); kind = k + 1; } }
    int K, NS, ND, KD; size_t off; const float* src; const float* gain = nullptr;
    switch (kind) {
#define WCASE(kk) case kk: K = wkind(kk).K; NS = wkind(kk).NS; ND = wkind(kk).ND; KD = wkind(kk).KD; off = wkind(kk).off; break;
        WCASE(WK_IN_E) WCASE(WK_UQ) WCASE(WK_UKV) WCASE(WK_OUT_E) WCASE(WK_IN_O) WCASE(WK_OUT_O) WCASE(WK_GU_D) WCASE(WK_DN_D) WCASE(WK_GU_M) default: WCASE(WK_DN_M)
#undef WCASE
    }
    const int per = (KD / 64) * (ND / 256); const int inst = (int)(r / per), ii = (int)(r % per), nb = ii / (KD / 64), kb = ii % (KD / 64);
    switch (kind) {
    case WK_IN_E: src = p.w_in_e; gain = p.mix_g + (2 * inst) * D; break;
    case WK_UQ: src = p.w_uq; gain = p.qn_g + inst * 256; break;
    case WK_UKV: src = p.w_ukv; gain = p.kvn_g + inst * 128; break;
    case WK_OUT_E: src = p.w_out_e; break;
    case WK_IN_O: src = p.w_in_o; gain = p.mix_g + (2 * inst + 1) * D; break;
    case WK_OUT_O: src = p.w_out_o; break;
    case WK_GU_D: src = p.w_gu_d; gain = p.ffn_g + (2 * inst) * D; break;
    case WK_DN_D: src = p.w_dn_d; break;
    case WK_GU_M: src = p.w_gu_m; gain = p.ffn_g + (2 * (inst >> 3) + 1) * D; break;
    default: src = p.w_dn_m; break;
    }
    WItem w; w.W = src + (size_t)inst * K * NS; w.gain = gain; w.K = K; w.NS = NS; w.KD = KD; w.kind = kind; w.k0 = 64 * kb; w.n0 = 256 * nb;
    const bool f8 = (MOE_FP8 && (kind == WK_GU_M || kind == WK_DN_M)) || (kind == WK_GU_D && ((FFN8_GU >> inst) & 1)) || (kind == WK_DN_D && ((FFN8_DN >> inst) & 1));
    w.fp8 = f8 ? 1 : 0; w.wscale = f8 ? ((kind == WK_GU_M || kind == WK_GU_D) ? 64.f : 128.f) : 1.f;
    w.dst = p.ws + WS_W + off + (size_t)inst * ND * KD * ((kind == WK_GU_M || kind == WK_DN_M) && MOE_FP8 ? 1 : 2);
    return w;
}
constexpr int WC_LD = 257;
__device__ __forceinline__ void wconv_load(const WItem& w, int wave, int lane, f32x4 (&v)[8], float& g, float& ls) {
    const int sc = srccol(w.kind, w.n0 + 4 * lane), scc = sc >= 0 ? sc : 0, kb = w.k0 + 8 * wave;
    ls = sc >= 0 ? w.wscale : 0.f;
    const float* gp = w.gain ? w.gain : w.W;
    { int k = kb + (lane & 7); k = k < w.K ? k : 0; g = gp[k]; }
#pragma unroll
    for (int i = 0; i < 8; ++i) { int k = kb + i; k = k < w.K ? k : 0; v[i] = *(const f32x4*)(w.W + (size_t)k * w.NS + scc); }
}
__device__ __forceinline__ void wconv_lds_write(const WItem& w, int wave, int lane, const f32x4 (&v)[8], float g, float ls, LAS float* tl) {
    const int kb = w.k0 + 8 * wave;
#pragma unroll
    for (int i = 0; i < 8; ++i) {
        const float gi = __int_as_float(__builtin_amdgcn_readlane(__float_as_int(g), i));
        const float s = (kb + i < w.K) ? (w.gain ? ls * gi : ls) : 0.f;
        LAS float* d = tl + (8 * wave + i) * WC_LD + 4 * lane; d[0] = v[i].x * s; d[1] = v[i].y * s; d[2] = v[i].z * s; d[3] = v[i].w * s; }
}
__device__ __forceinline__ void wconv_lds_read_store(const WItem& w, int wave, int lane, LAS float* tl) {
    const int tid = wave * 64 + lane;
    if (w.fp8) {
#pragma unroll
        for (int q = 0; q < 2; ++q) { const int task = tid + 512 * q, n = task >> 2, c = task & 3; const LAS float* s = tl + (16 * c) * WC_LD + n;
            unsigned ww[4];
#pragma unroll
            for (int j = 0; j < 4; ++j) { const LAS float* t = s + (4 * j) * WC_LD; int x = __builtin_amdgcn_cvt_pk_fp8_f32(t[0], t[WC_LD], 0, false); x = __builtin_amdgcn_cvt_pk_fp8_f32(t[2 * WC_LD], t[3 * WC_LD], x, true); ww[j] = (unsigned)x; }
            *(v4u*)(w.dst + (size_t)(w.n0 + n) * w.KD + w.k0 + 16 * c) = (v4u){ww[0], ww[1], ww[2], ww[3]}; }
    } else {
#pragma unroll
        for (int q = 0; q < 4; ++q) { const int task = tid + 512 * q, n = task >> 3, c = task & 7; const LAS float* s = tl + (8 * c) * WC_LD + n;
            v4u o; o.x = pk2(s[0], s[WC_LD]); o.y = pk2(s[2 * WC_LD], s[3 * WC_LD]); o.z = pk2(s[4 * WC_LD], s[5 * WC_LD]); o.w = pk2(s[6 * WC_LD], s[7 * WC_LD]);
            *(v4u*)((bf16*)w.dst + (size_t)(w.n0 + n) * w.KD + w.k0 + 8 * c) = o; }
    }
}
__device__ __forceinline__ void wconv_store(const WItem& w, int wave, int lane, const f32x4 (&v)[8], float g, float ls, LAS float* tl) {
    wconv_lds_write(w, wave, lane, v, g, ls, tl);
    __syncthreads();
    wconv_lds_read_store(w, wave, lane, tl);
    __syncthreads();
}
#ifndef MOE_CONV_OVL
#define MOE_CONV_OVL 1
#endif
constexpr int MOE_CONV_PER_WG = 21, MOE_CONV_BLOCKS = 5376, WCONV_LDS_OFF = 69632;
static_assert(MOE_CONV_BLOCKS == 8 * (16 * 28 + 56 * 4) && MOE_CONV_BLOCKS == 256 * MOE_CONV_PER_WG, "expert weight blocks per odd layer");
__device__ __forceinline__ long witems_before(int kind) { long t = 0;
#pragma unroll
    for (int k = 0; k < WK_N; ++k) if (k < kind) t += witems(k);
    return t; }
__device__ __forceinline__ WItem moe_conv_item(const P& p, int pr, int q) {
    const long it = q < 3584 ? witems_before(WK_GU_M) + (long)pr * 3584 + q : witems_before(WK_DN_M) + (long)pr * 1792 + (q - 3584);
    return wconv_decode(p, it);
}
__device__ __forceinline__ void ph_wconv(const P& p, LAS unsigned char* lds, int bid, int nblk) {
    const int tid = threadIdx.x, lane = tid & 63, wave = __builtin_amdgcn_readfirstlane(tid >> 6);
    LAS float* tl = (LAS float*)lds;
    long total = 0;
#pragma unroll
    for (int k = 0; k < WK_N; ++k) total += witems(k);
    if (nblk == 256 && MOE_FP8 && MOE_CONV_OVL) total = witems_before(WK_GU_M);
    if (bid >= total) return;
    WItem cur = wconv_decode(p, bid); f32x4 v[8]; float g, ls; wconv_load(cur, wave, lane, v, g, ls);
    for (long it = bid; it < total; it += nblk) {
        const bool more = it + nblk < total;
        WItem nxt = cur; f32x4 vn[8]; float gn = 0.f, lsn = 0.f;
        if (more) { nxt = wconv_decode(p, it + nblk); wconv_load(nxt, wave, lane, vn, gn, lsn); }
        wconv_store(cur, wave, lane, v, g, ls, tl);
        if (more) { cur = nxt; g = gn; ls = lsn;
#pragma unroll
            for (int i = 0; i < 8; ++i) v[i] = vn[i]; }
    }
}

namespace pg8 {
typedef int v4i __attribute__((ext_vector_type(4))); typedef int v8i __attribute__((ext_vector_type(8)));
constexpr int BM = 256, BK = 64, HALF = 128, HTB = HALF * BK * 2, NXCD = 8, WGM = 8;
__host__ __device__ __forceinline__ int lds_byte(int r, int c) { const int st = (r >> 4) * 2 + (c >> 5), rr = r & 15, cc = c & 31, ob = rr * 64 + cc * 2; return st * 1024 + (ob ^ (((ob >> 9) & 1) << 5)); }
__host__ __device__ __forceinline__ void stage_rc(int b, int& R, int& C) { const int st = b / 1024, sb = b % 1024, swz = sb ^ (((sb >> 9) & 1) << 5); R = (st >> 1) * 16 + swz / 64; C = (st & 1) * 32 + (swz % 64) / 2; }
__host__ __device__ __forceinline__ int perm32(int rho) { const int n = rho >> 4, i = rho & 15; return 8 * (i >> 2) + 4 * n + (i & 3); }

struct Unit { int pm, pn, e; };
struct Gemm { unsigned char* ws; unsigned aoff, boff; int N, K; };

struct StaticOrder {
    int nM, nN, nwg, G, c; const int* seg;
    __device__ __forceinline__ void init(int M, int N, int G_, int c_, const int* seg_) { asm volatile("" : "+s"(G_), "+s"(c_));
        seg = seg_; nM = (seg_ ? __builtin_amdgcn_readfirstlane(seg_[8]) : M) / BM; nN = N / BM; nwg = nM * nN; G = G_; c = c_; }
    __device__ __forceinline__ bool next(int i, Unit& u) const {
        const long L = (long)i * G + c; if (L >= nwg) return false;
        int wgid = (int)L; { const int q = nwg / NXCD, r = nwg % NXCD, xcd = wgid % NXCD, off = wgid / NXCD; wgid = (xcd < r ? xcd * (q + 1) : r * (q + 1) + (xcd - r) * q) + off; }
        const int nig = WGM * nN, gid = wgid / nig, fm = gid * WGM, gsz = (nM - fm) < WGM ? (nM - fm) : WGM;
        u.pm = fm + ((wgid % nig) % gsz); u.pn = (wgid % nig) / gsz; u.e = 0;
        if (gid & 1) u.pn = nN - 1 - u.pn;
        if (seg) { int e = 0;
#pragma unroll
            for (int q = 1; q < 8; ++q) e += (seg[q] <= u.pm * BM) ? 1 : 0;
            u.e = __builtin_amdgcn_readfirstlane(e); }
        return true;
    }
};

template <class Epi, class Sched, bool FP8 = false>
__device__ __forceinline__ void gemm_phase(LAS unsigned char* lds, const Gemm g, const Sched& S, const Epi& E) {
    int tid = threadIdx.x; asm volatile("" : "+v"(tid));
    const int wid = __builtin_amdgcn_readfirstlane(tid >> 6), lane = tid & 63, wr = wid >> 2, wc = wid & 3, fr = lane & 15, fq = lane >> 4;
    constexpr unsigned EB = FP8 ? 1u : 2u;
    const int K = g.K, nt = FP8 ? K / 128 : K / BK;
    unsigned voffA, voffB;
    { int R, C; stage_rc(tid * 16, R, C); const int Rb = (R & ~31) + perm32(R & 31);
      voffA = (unsigned)(R * K) * EB + (unsigned)C * 2u; voffB = (unsigned)(Rb * K) * EB + (unsigned)C * 2u; }
    const unsigned r64 = 64u * (unsigned)K * EB;
    const unsigned kstep = (unsigned)(BK * 2);
    const unsigned hstep = (unsigned)HALF * K * EB;
    const unsigned tstep = 2 * hstep;
    unsigned char* wsb = g.ws; asm volatile("" : "+s"(wsb));
    const unsigned ldsw = (unsigned)wid * 1024u;
    const int aoff = lds_byte(wr * 64 + fr, fq * 8), boff = lds_byte(wc * 32 + fr, fq * 8);
#define PG8_SA(b, h) (((b) * 2 + (h)) * HTB)
#define PG8_SB(b, h) ((4 + (b) * 2 + (h)) * HTB)
#define PG8_STAGE(bufoff, goff, voff) do { _Pragma("unroll") for (int _i = 0; _i < 2; ++_i) \
        __builtin_amdgcn_global_load_lds((const unsigned*)(wsb + (unsigned)((goff) + _i * r64 + (voff))), (LAS unsigned*)(lds + (bufoff) + ldsw + _i * 8192), 16, 0, 0); } while (0)
#define PG8_LDA(dst, b, h) do { _Pragma("unroll") for (int m = 0; m < 4; ++m) _Pragma("unroll") for (int k = 0; k < 2; ++k) dst[m][k] = *(const LAS bf16x8*)(lds + PG8_SA(b, h) + aoff + m * 2048 + k * 1024); } while (0)
#define PG8_LDB(dst, b, h) do { _Pragma("unroll") for (int n = 0; n < 2; ++n) _Pragma("unroll") for (int k = 0; k < 2; ++k) dst[n][k] = *(const LAS bf16x8*)(lds + PG8_SB(b, h) + boff + n * 2048 + k * 1024); } while (0)
#define PG8_MMA(ai, bj, At, Bt) do { __builtin_amdgcn_s_setprio(1); _Pragma("unroll") for (int m = 0; m < 4; ++m) _Pragma("unroll") for (int n = 0; n < 2; ++n) { \
        if constexpr (FP8) { const v8i _bb = __builtin_shufflevector(__builtin_bit_cast(v4i, Bt[n][0]), __builtin_bit_cast(v4i, Bt[n][1]), 0, 1, 2, 3, 4, 5, 6, 7), \
                                       _aa = __builtin_shufflevector(__builtin_bit_cast(v4i, At[m][0]), __builtin_bit_cast(v4i, At[m][1]), 0, 1, 2, 3, 4, 5, 6, 7); \
            asm volatile("v_mfma_scale_f32_16x16x128_f8f6f4 %0, %1, %2, %0, %3, %3 op_sel_hi:[0,0,0]" : "+v"(acc[ai][bj][m][n]) : "v"(_bb), "v"(_aa), "v"(0x7f7f7f7f)); }   \
        else { _Pragma("unroll") for (int k = 0; k < 2; ++k) acc[ai][bj][m][n] = __builtin_amdgcn_mfma_f32_16x16x32_bf16(Bt[n][k], At[m][k], acc[ai][bj][m][n], 0, 0, 0); } } \
        __builtin_amdgcn_s_setprio(0); } while (0)
#define PG8_WAIT_V(n) asm volatile("s_waitcnt vmcnt(" #n ")" ::: "memory")
#define PG8_WAIT_L(n) asm volatile("s_waitcnt lgkmcnt(" #n ")" ::: "memory")
#define PG8_BAR __builtin_amdgcn_s_barrier()
#define PG8_SCHED __builtin_amdgcn_sched_barrier(0)
#define PG8_BPTR(u) (g.boff + (unsigned)((u).e * g.N + (u).pn * BM) * (unsigned)K * EB)
    Unit cur, nxt; int ui = 0;
    if (!S.next(0, cur)) return;
    f32x4 acc[2][2][4][2];
#pragma unroll
    for (int a = 0; a < 2; ++a)
#pragma unroll
        for (int b = 0; b < 2; ++b)
#pragma unroll
            for (int m = 0; m < 4; ++m)
#pragma unroll
                for (int n = 0; n < 2; ++n) acc[a][b][m][n] = (f32x4){0.f, 0.f, 0.f, 0.f};
    bf16x8 At[4][2], B0[2][2], B1[2][2];
    unsigned cA = g.aoff + (unsigned)cur.pm * tstep, cB = PG8_BPTR(cur);
    PG8_STAGE(PG8_SB(0, 0), cB, voffB); PG8_STAGE(PG8_SB(0, 1), cB + hstep, voffB); PG8_STAGE(PG8_SA(0, 0), cA, voffA); PG8_STAGE(PG8_SA(0, 1), cA + hstep, voffA);
    if (wr == 1) PG8_BAR;
    PG8_WAIT_V(2); PG8_BAR;
    PG8_STAGE(PG8_SB(1, 0), cB + kstep, voffB); PG8_STAGE(PG8_SA(1, 0), cA + kstep, voffA); PG8_STAGE(PG8_SB(1, 1), cB + hstep + kstep, voffB);
    PG8_WAIT_V(6); PG8_BAR;
    for (;;) {
        const bool has_next = S.next(ui + 1, nxt);
        const unsigned nA = has_next ? g.aoff + (unsigned)nxt.pm * tstep : cA, nB = has_next ? PG8_BPTR(nxt) : cB;
        for (int t = 0; t < nt; t += 2) {
            const bool last = (t == nt - 2);
            const unsigned a1 = cA + (unsigned)(t + 1) * kstep;
            const unsigned a2 = last ? nA : cA + (unsigned)(t + 2) * kstep, b2 = last ? nB : cB + (unsigned)(t + 2) * kstep;
            const unsigned a3 = a2 + kstep, b3 = b2 + kstep;
            PG8_LDB(B0, 0, 0); PG8_LDB(B1, 0, 1); PG8_SCHED; PG8_LDA(At, 0, 0); PG8_STAGE(PG8_SA(1, 1), a1 + hstep, voffA);
            PG8_WAIT_V(8); PG8_WAIT_L(0); PG8_BAR; PG8_MMA(0, 0, At, B0); PG8_MMA(0, 1, At, B1); PG8_BAR; PG8_SCHED;
            PG8_LDA(At, 0, 1); PG8_STAGE(PG8_SB(0, 0), b2, voffB); PG8_STAGE(PG8_SB(0, 1), b2 + hstep, voffB); PG8_STAGE(PG8_SA(0, 0), a2, voffA);
            PG8_WAIT_V(8); PG8_WAIT_L(0); PG8_BAR; PG8_MMA(1, 0, At, B0); PG8_MMA(1, 1, At, B1); PG8_BAR; PG8_SCHED;
            PG8_LDB(B0, 1, 0); PG8_LDB(B1, 1, 1); PG8_SCHED; PG8_LDA(At, 1, 0); PG8_STAGE(PG8_SA(0, 1), a2 + hstep, voffA);
            PG8_WAIT_V(8); PG8_WAIT_L(0); PG8_BAR; PG8_MMA(0, 0, At, B0); PG8_MMA(0, 1, At, B1); PG8_BAR; PG8_SCHED;
            PG8_LDA(At, 1, 1); PG8_STAGE(PG8_SB(1, 0), b3, voffB); PG8_STAGE(PG8_SB(1, 1), b3 + hstep, voffB); PG8_STAGE(PG8_SA(1, 0), a3, voffA);
            PG8_WAIT_V(8); PG8_WAIT_L(0); PG8_BAR; PG8_MMA(1, 0, At, B0); PG8_MMA(1, 1, At, B1); PG8_BAR; PG8_SCHED;
        }
        if (wr == 0) PG8_BAR;
        if constexpr (FP8) { PG8_SCHED; asm volatile("s_nop 15\n\ts_nop 7" ::: "memory"); PG8_SCHED; }
        { int t2 = threadIdx.x; asm volatile("" : "+v"(t2)); const int l2 = t2 & 63;
          E(acc, cur, wr, wc, l2 & 15, l2 >> 4); }
        if (!has_next) break;
#pragma unroll
        for (int a = 0; a < 2; ++a)
#pragma unroll
            for (int b = 0; b < 2; ++b)
#pragma unroll
                for (int m = 0; m < 4; ++m)
#pragma unroll
                    for (int n = 0; n < 2; ++n) acc[a][b][m][n] = (f32x4){0.f, 0.f, 0.f, 0.f};
        cur = nxt; cA = nA; cB = nB; ++ui;
        if (wr == 1) PG8_BAR;
    }
    PG8_WAIT_V(0);
    PG8_BAR;
#undef PG8_SA
#undef PG8_SB
#undef PG8_STAGE
#undef PG8_LDA
#undef PG8_LDB
#undef PG8_MMA
#undef PG8_WAIT_V
#undef PG8_WAIT_L
#undef PG8_BAR
#undef PG8_SCHED
#undef PG8_BPTR
}
}

typedef const f32x4 (&AccRef)[2][2][4][2];
template <class TT> __device__ __forceinline__ TT& wsat(unsigned char* ws, unsigned off) { return *(TT*)(ws + off); }
__device__ __forceinline__ v4u pack8(f32x4 a, f32x4 b, float s) { v4u w; w.x = pk2(a.x * s, a.y * s); w.y = pk2(a.z * s, a.w * s); w.z = pk2(b.x * s, b.y * s); w.w = pk2(b.z * s, b.w * s); return w; }
__device__ __forceinline__ float ssq8(f32x4 a, f32x4 b, float s) { a = a * s; b = b * s; return (a.x * a.x + a.y * a.y) + (a.z * a.z + a.w * a.w) + (b.x * b.x + b.y * b.y) + (b.z * b.z + b.w * b.w); }
__device__ __forceinline__ float fq_sum(float v) { v += __shfl_xor(v, 16); v += __shfl_xor(v, 32); return v; }
constexpr int EPI_LDS_OFF = 131072;
__device__ __forceinline__ void vt_store(unsigned char* ws, LAS unsigned char* lds, int wid, unsigned vt_off, f32x4 a, f32x4 b, float s, int fr, int fq) {
    LAS bf16* scr = (LAS bf16*)(lds + EPI_LDS_OFF + wid * 1024);
    const int p = permk(fr), lane = fq * 16 + fr;
    LAS bf16* w = scr + (8 * fq) * 16 + p;
    w[0 * 16] = (bf16)f2bf(a.x * s); w[1 * 16] = (bf16)f2bf(a.y * s); w[2 * 16] = (bf16)f2bf(a.z * s); w[3 * 16] = (bf16)f2bf(a.w * s);
    w[4 * 16] = (bf16)f2bf(b.x * s); w[5 * 16] = (bf16)f2bf(b.y * s); w[6 * 16] = (bf16)f2bf(b.z * s); w[7 * 16] = (bf16)f2bf(b.w * s);
    asm volatile("s_waitcnt lgkmcnt(0)" ::: "memory");
    const v4u x = *(const LAS v4u*)(scr + (lane >> 1) * 16 + (lane & 1) * 8);
    wsat<v4u>(ws, vt_off + ((unsigned)(lane >> 1) * SEQ + (lane & 1) * 8) * 2u) = x;
    asm volatile("s_waitcnt lgkmcnt(0)" ::: "memory");
}
#define EPI_ROW(ai, m) ((unsigned)(u.pm * 256 + (ai) * 128 + wr * 64 + (m) * 16 + fr))
#define EPI_FOR_AI _Pragma("unroll") for (int ai = 0; ai < 2; ++ai)
#define EPI_FOR_M _Pragma("unroll") for (int m = 0; m < 4; ++m)
constexpr unsigned OA(size_t a) { return (unsigned)(WS_AR + a); }
__device__ __forceinline__ void epi_rstd16(unsigned char* ws, const pg8::Unit& u, int wr, int fr, int fq, float (&rs)[8]) {
    f32x4 part[8];
    EPI_FOR_AI EPI_FOR_M part[ai * 4 + m] = wsat<f32x4>(ws, (unsigned)WS_SSQ + EPI_ROW(ai, m) * 64u + (unsigned)fq * 16u);
#pragma unroll
    for (int i = 0; i < 8; ++i) { const float t = fq_sum((part[i].x + part[i].y) + (part[i].z + part[i].w)); rs[i] = 1.0f / sqrtf(t * (1.f / D) + EPS); }
}
__device__ __forceinline__ void epi_rstd4(unsigned char* ws, unsigned off, float invn, const pg8::Unit& u, int wr, int fr, float (&rs)[8]) {
    f32x4 part[8];
    EPI_FOR_AI EPI_FOR_M part[ai * 4 + m] = wsat<f32x4>(ws, off + EPI_ROW(ai, m) * 16u);
#pragma unroll
    for (int i = 0; i < 8; ++i) rs[i] = 1.0f / sqrtf(((part[i].x + part[i].y) + (part[i].z + part[i].w)) * invn + EPS);
}
__device__ __forceinline__ float clamp448(float v) { return __builtin_amdgcn_fmed3f(v, -448.f, 448.f); }
__device__ __forceinline__ unsigned pk4_fp8(float a, float b, float c, float d) { int w = __builtin_amdgcn_cvt_pk_fp8_f32(clamp448(a), clamp448(b), 0, false); w = __builtin_amdgcn_cvt_pk_fp8_f32(clamp448(c), clamp448(d), w, true); return (unsigned)w; }
constexpr float FP8_WS_GU = 64.f, FP8_WS_DN = 128.f, FP8_AS = 4.f;

__device__ const float RFB[16] = {1.591549431e-01f, 8.949940161e-02f, 5.032921210e-02f, 2.830219583e-02f, 1.591549431e-02f, 8.949940161e-03f, 5.032921210e-03f, 2.830219583e-03f, 1.591549431e-03f, 8.949940161e-04f, 5.032921210e-04f, 2.830219583e-04f, 1.591549431e-04f, 8.949940161e-05f, 5.032921210e-05f, 2.830219583e-05f};
__device__ const float RFC[32] = {1.591549431e-01f, 1.193493702e-01f, 8.949940161e-02f, 6.711508301e-02f, 5.032921210e-02f, 3.774158472e-02f, 2.830219583e-02f, 2.122365276e-02f, 1.591549431e-02f, 1.193493702e-02f, 8.949940161e-03f, 6.711508301e-03f, 5.032921210e-03f, 3.774158472e-03f, 2.830219583e-03f, 2.122365276e-03f, 1.591549431e-03f, 1.193493702e-03f, 8.949940161e-04f, 6.711508301e-04f, 5.032921210e-04f, 3.774158472e-04f, 2.830219583e-04f, 2.122365276e-04f, 1.591549431e-04f, 1.193493702e-04f, 8.949940161e-05f, 6.711508301e-05f, 5.032921210e-05f, 3.774158472e-05f, 2.830219583e-05f, 2.122365276e-05f};
__device__ __forceinline__ void rope_cs8(float posf, const float (&rf)[8], f32x4& c0, f32x4& c1, f32x4& s0, f32x4& s1) {
    float c[8], s[8];
#pragma unroll
    for (int e = 0; e < 8; ++e) { const float r = __builtin_amdgcn_fractf(posf * rf[e]); c[e] = __builtin_amdgcn_cosf(r); s[e] = __builtin_amdgcn_sinf(r); }
    c0 = (f32x4){c[0], c[1], c[2], c[3]}; c1 = (f32x4){c[4], c[5], c[6], c[7]}; s0 = (f32x4){s[0], s[1], s[2], s[3]}; s1 = (f32x4){s[4], s[5], s[6], s[7]};
}
struct EpiEvenIn {
    unsigned char* ws; LAS unsigned char* lds; const int* pos;
    __device__ __forceinline__ void operator()(AccRef acc, const pg8::Unit& u, int wr, int wc, int fr, int fq) const {
        const int pn = u.pn; const unsigned c8 = 32 * wc + 8 * fq;
        float rsv[8]; epi_rstd16(ws, u, wr, fr, fq, rsv);
        int posv[8]; float rf[8];
        if (pn == 7 && wc == 0) { EPI_FOR_AI EPI_FOR_M posv[ai * 4 + m] = pos[EPI_ROW(ai, m)];
#pragma unroll
            for (int e = 0; e < 8; ++e) rf[e] = RFB[8 * (fq & 1) + e]; }
        EPI_FOR_AI {
            EPI_FOR_M { const unsigned row = EPI_ROW(ai, m); const float rs = rsv[ai * 4 + m];
            if (pn < 4) { const unsigned o = (pn < 2 ? OA(AR_QA) : OA(AR_KA)) + (row * 512u + (pn & 1) * 256u + c8) * 2u; const float s = pn < 2 ? rs * (0.125f * LOG2E) : rs;
                wsat<v4u>(ws, o) = pack8(acc[ai][0][m][0], acc[ai][0][m][1], s); wsat<v4u>(ws, o + 256) = pack8(acc[ai][1][m][0], acc[ai][1][m][1], s); }
            else if (pn < 6) { const unsigned r16 = row - fr, b = r16 / SEQ, s16 = r16 % SEQ;
                _Pragma("unroll") for (int bj = 0; bj < 2; ++bj) { const unsigned cc = (pn - 4) * 256 + 128 * bj + 32 * wc, h = cc >> 6, d0 = cc & 63;
                    vt_store(ws, lds, wr * 4 + wc, OA(AR_VAT) + (((b * 8 + h) * 64 + d0) * SEQ + s16) * 2u, acc[ai][bj][m][0], acc[ai][bj][m][1], rs, fr, fq); } }
            else if (pn == 6) { const unsigned o = OA(AR_CQ) + (row * 256u + c8) * 2u;
                wsat<v4u>(ws, o) = pack8(acc[ai][0][m][0], acc[ai][0][m][1], rs); wsat<v4u>(ws, o + 256) = pack8(acc[ai][1][m][0], acc[ai][1][m][1], rs);
                const float ss = fq_sum(ssq8(acc[ai][0][m][0], acc[ai][0][m][1], rs) + ssq8(acc[ai][1][m][0], acc[ai][1][m][1], rs));
                if (fq == 0) wsat<float>(ws, (unsigned)WS_SSQQ + (row * 4u + wc) * 4u) = ss; }
            else { const unsigned o = OA(AR_CKV) + (row * 256u + c8) * 2u;
                wsat<v4u>(ws, o) = pack8(acc[ai][0][m][0], acc[ai][0][m][1], rs); wsat<v4u>(ws, o + 256) = (v4u){0u, 0u, 0u, 0u};
                const float ss = fq_sum(ssq8(acc[ai][0][m][0], acc[ai][0][m][1], rs));
                if (fq == 0) wsat<float>(ws, (unsigned)WS_SSQKV + (row * 4u + wc) * 4u) = ss;
                if (wc == 0) {
                    const f32x4 a = acc[ai][1][m][0] * rs, bq = acc[ai][1][m][1] * rs;
                    float own[8] = {a.x, a.y, a.z, a.w, bq.x, bq.y, bq.z, bq.w}; float o8[8];
                    const unsigned j0 = 8 * (fq & 1);
                    f32x4 c0, c1, s0, s1; rope_cs8((float)posv[ai * 4 + m], rf, c0, c1, s0, s1);
                    const float cs[8] = {c0.x, c0.y, c0.z, c0.w, c1.x, c1.y, c1.z, c1.w}, sn[8] = {s0.x, s0.y, s0.z, s0.w, s1.x, s1.y, s1.z, s1.w};
                    _Pragma("unroll") for (int e = 0; e < 8; ++e) { const float oth = __shfl_xor(own[e], 32); o8[e] = fq < 2 ? own[e] * cs[e] - oth * sn[e] : oth * sn[e] + own[e] * cs[e]; }
                    v4u w; w.x = pk2(o8[0], o8[1]); w.y = pk2(o8[2], o8[3]); w.z = pk2(o8[4], o8[5]); w.w = pk2(o8[6], o8[7]);
                    const unsigned kb = OA(AR_KB) + (row * 768u + 64 + 16 * (fq >> 1) + j0) * 2u;
                    _Pragma("unroll") for (int h = 0; h < 8; ++h) wsat<v4u>(ws, kb + h * 192) = w; } }
            }
        }
    }
};
struct EpiUq {
    unsigned char* ws; const int* pos;
    __device__ __forceinline__ void operator()(AccRef acc, const pg8::Unit& u, int wr, int wc, int fr, int fq) const {
        const int pn = u.pn; const float sc = 0.10206207261596575f * LOG2E;
        float rsv[8]; epi_rstd4(ws, (unsigned)WS_SSQQ, 1.f / 256, u, wr, fr, rsv);
        int posv[8]; float rf[8];
        if (pn == 2) { EPI_FOR_AI EPI_FOR_M posv[ai * 4 + m] = pos[EPI_ROW(ai, m)];
#pragma unroll
            for (int e = 0; e < 8; ++e) rf[e] = RFB[8 * (fq & 1) + e]; }
        EPI_FOR_AI {
            EPI_FOR_M { const unsigned row = EPI_ROW(ai, m); const float rs = rsv[ai * 4 + m] * sc; const unsigned qrow = OA(AR_QB) + row * 1536u;
            if (pn < 2) { _Pragma("unroll") for (int bj = 0; bj < 2; ++bj) { const unsigned h = 4 * pn + 2 * bj + (wc >> 1), d = 32 * (wc & 1) + 8 * fq;
                    wsat<v4u>(ws, qrow + (h * 96 + d) * 2u) = pack8(acc[ai][bj][m][0], acc[ai][bj][m][1], rs); } }
            else { const unsigned head = 2 * wc + (fq >> 1), j0 = 8 * (fq & 1);
                f32x4 c0, c1, s0, s1; rope_cs8((float)posv[ai * 4 + m], rf, c0, c1, s0, s1);
                const f32x4 x10 = acc[ai][0][m][0], x11 = acc[ai][0][m][1], x20 = acc[ai][1][m][0], x21 = acc[ai][1][m][1];
                wsat<v4u>(ws, qrow + (head * 96 + 64 + j0) * 2u) = pack8(x10 * c0 - x20 * s0, x11 * c1 - x21 * s1, rs);
                wsat<v4u>(ws, qrow + (head * 96 + 80 + j0) * 2u) = pack8(x10 * s0 + x20 * c0, x11 * s1 + x21 * c1, rs); }
            }
        }
    }
};
struct EpiUkv {
    unsigned char* ws; LAS unsigned char* lds;
    __device__ __forceinline__ void operator()(AccRef acc, const pg8::Unit& u, int wr, int wc, int fr, int fq) const {
        float rsv[8]; epi_rstd4(ws, (unsigned)WS_SSQKV, 1.f / 128, u, wr, fr, rsv);
        EPI_FOR_AI EPI_FOR_M { const unsigned row = EPI_ROW(ai, m); const float rs = rsv[ai * 4 + m]; const unsigned r16 = row - fr, b = r16 / SEQ, s16 = r16 % SEQ;
            _Pragma("unroll") for (int bj = 0; bj < 2; ++bj) { const unsigned h = 2 * u.pn + bj;
                if (wc < 2) wsat<v4u>(ws, OA(AR_KB) + (row * 768u + h * 96 + 32 * wc + 8 * fq) * 2u) = pack8(acc[ai][bj][m][0], acc[ai][bj][m][1], rs);
                else vt_store(ws, lds, wr * 4 + wc, OA(AR_VBT) + (((b * 8 + h) * 64 + 32 * (wc - 2)) * SEQ + s16) * 2u, acc[ai][bj][m][0], acc[ai][bj][m][1], rs, fr, fq); }
        }
    }
};
template <bool W8, bool WB = true> struct EpiRes {
    unsigned char* ws; const float* res; float oscale;
    __device__ __forceinline__ void operator()(AccRef acc, const pg8::Unit& u, int wr, int wc, int fr, int fq) const {
#if H_BF16
        v4u rv[8][2];
        EPI_FOR_AI EPI_FOR_M _Pragma("unroll") for (int bj = 0; bj < 2; ++bj) rv[ai * 4 + m][bj] = wsat<v4u>(ws, (unsigned)WS_HB + (EPI_ROW(ai, m) * 1024u + u.pn * 256 + 128 * bj + 32 * wc + 8 * fq) * 2u);
        EPI_FOR_AI EPI_FOR_M { const unsigned row = EPI_ROW(ai, m);
            float ss = 0.f;
            _Pragma("unroll") for (int bj = 0; bj < 2; ++bj) { const unsigned e = row * 1024u + u.pn * 256 + 128 * bj + 32 * wc + 8 * fq; const v4u t = rv[ai * 4 + m][bj];
                const f32x4 h0 = (f32x4){bf2f(t.x & 0xffffu), bf2f(t.x >> 16), bf2f(t.y & 0xffffu), bf2f(t.y >> 16)} + acc[ai][bj][m][0] * oscale;
                const f32x4 h1 = (f32x4){bf2f(t.z & 0xffffu), bf2f(t.z >> 16), bf2f(t.w & 0xffffu), bf2f(t.w >> 16)} + acc[ai][bj][m][1] * oscale;
                if (W8) { v2u w8; w8.x = pk4_fp8(h0.x, h0.y, h0.z, h0.w); w8.y = pk4_fp8(h1.x, h1.y, h1.z, h1.w); wsat<v2u>(ws, OA(AR_HB8) + e) = w8; }
                wsat<v4u>(ws, (unsigned)WS_HB + e * 2u) = pack8(h0, h1, 1.f);
                if (WB) ss += ssq8(h0, h1, 1.f); }
            if (WB) { ss = fq_sum(ss);
            if (fq == 0) wsat<float>(ws, (unsigned)WS_SSQ + (row * 16u + 4 * u.pn + wc) * 4u) = ss; }
        }
#else
        EPI_FOR_AI {
            f32x4 rv[4][2][2];
            EPI_FOR_M _Pragma("unroll") for (int bj = 0; bj < 2; ++bj) { const unsigned e = EPI_ROW(ai, m) * 1024u + u.pn * 256 + 128 * bj + 32 * wc + 8 * fq;
                const f32x4* rp = (const f32x4*)((const unsigned char*)res + e * 4u); rv[m][bj][0] = rp[0]; rv[m][bj][1] = rp[1]; }
            EPI_FOR_M { const unsigned row = EPI_ROW(ai, m);
            float ss = 0.f;
            _Pragma("unroll") for (int bj = 0; bj < 2; ++bj) { const unsigned e = row * 1024u + u.pn * 256 + 128 * bj + 32 * wc + 8 * fq;
                const f32x4 h0 = rv[m][bj][0] + acc[ai][bj][m][0] * oscale, h1 = rv[m][bj][1] + acc[ai][bj][m][1] * oscale;
                if (W8) { v2u w8; w8.x = pk4_fp8(h0.x, h0.y, h0.z, h0.w); w8.y = pk4_fp8(h1.x, h1.y, h1.z, h1.w); wsat<v2u>(ws, OA(AR_HB8) + e) = w8; }
                wsat<f32x4>(ws, (unsigned)WS_H + e * 4u) = h0; wsat<f32x4>(ws, (unsigned)WS_H + e * 4u + 16) = h1;
                if (WB) { wsat<v4u>(ws, (unsigned)WS_HB + e * 2u) = pack8(h0, h1, 1.f); ss += ssq8(h0, h1, 1.f); } }
            if (WB) { ss = fq_sum(ss);
            if (fq == 0) wsat<float>(ws, (unsigned)WS_SSQ + (row * 16u + 4 * u.pn + wc) * 4u) = ss; }
            }
        }
#endif
    }
};
struct EpiOddIn {
    unsigned char* ws; LAS unsigned char* lds; const int* pos;
    __device__ __forceinline__ void operator()(AccRef acc, const pg8::Unit& u, int wr, int wc, int fr, int fq) const {
        const int pn = u.pn;
        float rsv[8]; epi_rstd16(ws, u, wr, fr, fq, rsv);
        int posv[8]; float rf[8];
        if (pn < 8) { EPI_FOR_AI EPI_FOR_M posv[ai * 4 + m] = pos[EPI_ROW(ai, m)];
#pragma unroll
            for (int e = 0; e < 8; ++e) rf[e] = RFC[8 * fq + e]; }
        EPI_FOR_AI {
            EPI_FOR_M { const unsigned row = EPI_ROW(ai, m); const float rs = rsv[ai * 4 + m];
            if (pn < 8) { const unsigned mm = 4 * (pn & 3) + wc, j0 = 8 * fq; const float s = pn < 4 ? rs * (0.125f * LOG2E) : rs;
                f32x4 c0, c1, s0, s1; rope_cs8((float)posv[ai * 4 + m], rf, c0, c1, s0, s1);
                const f32x4 x10 = acc[ai][0][m][0], x11 = acc[ai][0][m][1], x20 = acc[ai][1][m][0], x21 = acc[ai][1][m][1];
                const unsigned o = (pn < 4 ? OA(AR_QC) : OA(AR_KC)) + (row * 1024u + (mm >> 1) * 128 + (mm & 1) * 64 + j0) * 2u;
                wsat<v4u>(ws, o) = pack8(x10 * c0 - x20 * s0, x11 * c1 - x21 * s1, s);
                wsat<v4u>(ws, o + 64) = pack8(x10 * s0 + x20 * c0, x11 * s1 + x21 * c1, s); }
            else { const unsigned r16 = row - fr, b = r16 / SEQ, s16 = r16 % SEQ;
                _Pragma("unroll") for (int bj = 0; bj < 2; ++bj) { const unsigned h = 2 * (pn - 8) + bj;
                    vt_store(ws, lds, wr * 4 + wc, OA(AR_VCT) + (((b * 8 + h) * 128 + 32 * wc) * SEQ + s16) * 2u, acc[ai][bj][m][0], acc[ai][bj][m][1], rs, fr, fq); } }
            }
        }
    }
};
__device__ __forceinline__ float silu_mul(float g2, float u2) { return g2 * u2 * __builtin_amdgcn_rcpf(1.f + __builtin_amdgcn_exp2f(-g2)); }
template <bool NORM> struct EpiSwigluFp8 {
    unsigned char* ws; unsigned aoff; int ldc;
    __device__ __forceinline__ void operator()(AccRef acc, const pg8::Unit& u, int wr, int wc, int fr, int fq) const {
        float rsv[8];
        if (NORM) epi_rstd16(ws, u, wr, fr, fq, rsv);
        EPI_FOR_AI EPI_FOR_M { const unsigned row = EPI_ROW(ai, m);
            const float rs = (NORM ? rsv[ai * 4 + m] : 1.f) * (1.f / FP8_WS_GU);
            const f32x4 g0 = acc[ai][0][m][0] * (rs * LOG2E), g1 = acc[ai][0][m][1] * (rs * LOG2E), u0 = acc[ai][1][m][0] * (rs * (FP8_AS / LOG2E)), u1 = acc[ai][1][m][1] * (rs * (FP8_AS / LOG2E));
            v2u w; w.x = pk4_fp8(silu_mul(g0.x, u0.x), silu_mul(g0.y, u0.y), silu_mul(g0.z, u0.z), silu_mul(g0.w, u0.w));
            w.y = pk4_fp8(silu_mul(g1.x, u1.x), silu_mul(g1.y, u1.y), silu_mul(g1.z, u1.z), silu_mul(g1.w, u1.w));
            wsat<v2u>(ws, aoff + row * (unsigned)ldc + 128 * u.pn + 32 * wc + 8 * fq) = w;
        }
    }
};
template <bool NORM> struct EpiSwiglu {
    unsigned char* ws; unsigned aoff; int ldc;
    __device__ __forceinline__ void operator()(AccRef acc, const pg8::Unit& u, int wr, int wc, int fr, int fq) const {
        float rsv[8];
        if (NORM) epi_rstd16(ws, u, wr, fr, fq, rsv);
        EPI_FOR_AI EPI_FOR_M { const unsigned row = EPI_ROW(ai, m);
            const float rs = NORM ? rsv[ai * 4 + m] : 1.f;
            const f32x4 g0 = acc[ai][0][m][0] * (rs * LOG2E), g1 = acc[ai][0][m][1] * (rs * LOG2E), u0 = acc[ai][1][m][0] * (rs * (1.f / LOG2E)), u1 = acc[ai][1][m][1] * (rs * (1.f / LOG2E));
            v4u w; w.x = pk2(silu_mul(g0.x, u0.x), silu_mul(g0.y, u0.y)); w.y = pk2(silu_mul(g0.z, u0.z), silu_mul(g0.w, u0.w));
            w.z = pk2(silu_mul(g1.x, u1.x), silu_mul(g1.y, u1.y)); w.w = pk2(silu_mul(g1.z, u1.z), silu_mul(g1.w, u1.w));
            wsat<v4u>(ws, aoff + (row * (unsigned)ldc + 128 * u.pn + 32 * wc + 8 * fq) * 2u) = w;
        }
    }
};
template <bool NORM, bool W8, bool A8> struct EpiSwigluX {
    unsigned char* ws; unsigned aoff; int ldc;
    __device__ __forceinline__ void operator()(AccRef acc, const pg8::Unit& u, int wr, int wc, int fr, int fq) const {
        float rsv[8];
        if (NORM) epi_rstd16(ws, u, wr, fr, fq, rsv);
        EPI_FOR_AI EPI_FOR_M { const unsigned row = EPI_ROW(ai, m);
            const float rs = (NORM ? rsv[ai * 4 + m] : 1.f) * (W8 ? 1.f / FP8_WS_GU : 1.f), us = rs * (A8 ? FP8_AS : 1.f) * (1.f / LOG2E);
            const f32x4 g0 = acc[ai][0][m][0] * (rs * LOG2E), g1 = acc[ai][0][m][1] * (rs * LOG2E), u0 = acc[ai][1][m][0] * us, u1 = acc[ai][1][m][1] * us;
            if (A8) { v2u w; w.x = pk4_fp8(silu_mul(g0.x, u0.x), silu_mul(g0.y, u0.y), silu_mul(g0.z, u0.z), silu_mul(g0.w, u0.w));
                w.y = pk4_fp8(silu_mul(g1.x, u1.x), silu_mul(g1.y, u1.y), silu_mul(g1.z, u1.z), silu_mul(g1.w, u1.w));
                wsat<v2u>(ws, aoff + row * (unsigned)ldc + 128 * u.pn + 32 * wc + 8 * fq) = w; }
            else { v4u w; w.x = pk2(silu_mul(g0.x, u0.x), silu_mul(g0.y, u0.y)); w.y = pk2(silu_mul(g0.z, u0.z), silu_mul(g0.w, u0.w));
                w.z = pk2(silu_mul(g1.x, u1.x), silu_mul(g1.y, u1.y)); w.w = pk2(silu_mul(g1.z, u1.z), silu_mul(g1.w, u1.w));
                wsat<v4u>(ws, aoff + (row * (unsigned)ldc + 128 * u.pn + 32 * wc + 8 * fq) * 2u) = w; }
        }
    }
};
struct EpiMoeDown {
    unsigned char* ws; float oscale;
    __device__ __forceinline__ void operator()(AccRef acc, const pg8::Unit& u, int wr, int wc, int fr, int fq) const {
        int tiv[8]; float gtv[8];
        EPI_FOR_AI EPI_FOR_M { const unsigned row = EPI_ROW(ai, m); tiv[ai * 4 + m] = wsat<int>(ws, (unsigned)WS_TOKI + row * 4u); gtv[ai * 4 + m] = wsat<float>(ws, (unsigned)WS_GATE + row * 4u); }
        EPI_FOR_AI EPI_FOR_M { const int ti = tiv[ai * 4 + m];
            if (ti >= 0) { const float gt = gtv[ai * 4 + m] * oscale; const unsigned o = OA(AR_Y) + (((unsigned)(ti & 1) * T + (unsigned)(ti >> 1)) * 1024u + u.pn * 256 + 32 * wc + 8 * fq) * 2u;
                wsat<v4u>(ws, o) = pack8(acc[ai][0][m][0], acc[ai][0][m][1], gt); wsat<v4u>(ws, o + 256) = pack8(acc[ai][1][m][0], acc[ai][1][m][1], gt); }
        }
    }
};

__device__ __forceinline__ float xhalf_max(float m) { auto rr = __builtin_amdgcn_permlane32_swap(__float_as_uint(m), __float_as_uint(m), false, false); return fmaxf(__uint_as_float(rr[0]), __uint_as_float(rr[1])); }
__device__ __forceinline__ float xhalf_sum(float m) { auto rr = __builtin_amdgcn_permlane32_swap(__float_as_uint(m), __float_as_uint(m), false, false); return __uint_as_float(rr[0]) + __uint_as_float(rr[1]); }
__device__ __forceinline__ float max3f(float a, float b, float c) { float r; asm("v_max3_f32 %0, %1, %2, %3" : "=v"(r) : "v"(a), "v"(b), "v"(c)); return r; }
__device__ __forceinline__ int crow(int r, int hi) { return (r & 3) + 8 * (r >> 2) + 4 * hi; }
constexpr int ATT_TAB_OFF = 57344;

struct CvState { int done, step, next; };
#ifndef MOE_CONV_PERIOD
#define MOE_CONV_PERIOD 7
#endif
template <int MODE>
__device__ __forceinline__ void attn_unit(const P& p, LAS unsigned char* lds, int layer, int b, int h, int qb, float lam_init, float lam, CvState& cs, int cvid) {
    constexpr int DK = MODE == 0 ? 64 : (MODE == 1 ? 96 : 128), DQK = MODE == 1 ? 96 : 64, DV = MODE == 2 ? 128 : 64;
    constexpr int PITCH = MODE == 0 ? 512 : (MODE == 1 ? 768 : 1024), HD = MODE == 0 ? 64 : (MODE == 1 ? 96 : 128);
    constexpr int KROW = DK * 2 + 16, VROW = 144, KST = 64 * KROW, VST = DV * VROW, STAGE = KST + VST;
    constexpr int NKP = 64 * DK / 8, KPT = (NKP + 511) / 512, NVP = DV * 8, VPT = NVP / 512, NS = DQK / 16, NDV = DV / 32, CPR = DK / 8;
    static_assert(3 * STAGE <= (MODE == 0 ? ATT_TAB_OFF : LDSCTL_OFF) && 65536 <= LDSCTL_OFF, "attention LDS map");
    int tid = threadIdx.x; asm volatile("" : "+v"(tid));
    const int lane = tid & 63, w = __builtin_amdgcn_readfirstlane(tid >> 6), l31 = lane & 31, hi = lane >> 5;
    const int i2 = layer >> 1;
    unsigned char* ar = p.ws + WS_AR;
    const bf16* Q = (const bf16*)(ar + (MODE == 0 ? AR_QA : MODE == 1 ? AR_QB : AR_QC));
    const bf16* Kp = (const bf16*)(ar + (MODE == 0 ? AR_KA : MODE == 1 ? AR_KB : AR_KC));
    const bf16* VT = (const bf16*)(ar + (MODE == 0 ? AR_VAT : MODE == 1 ? AR_VBT : AR_VCT));
    bf16* O = (bf16*)(ar + AR_MIX);
    const int wq = MODE == 2 ? (w & 3) : w, kd0 = MODE == 2 ? (w >> 2) * 64 : 0;
    const int c0 = MODE == 2 ? qb * 2 : qb * 4, cq = c0 + (wq >> 1);
    const int qrow0 = c0 * 64 + 32 * wq;
    const int jhi_u = c0 + (MODE == 2 ? 1 : 3), jlo_u = MODE == 0 ? (c0 > 8 ? c0 - 8 : 0) : 0;
    const int jlo_w = MODE == 0 ? (cq > 8 ? cq - 8 : 0) : 0, jhi_w = cq;
    const bf16* Kg = Kp + (size_t)b * SEQ * PITCH + h * HD;
    const bf16* Vg = VT + (size_t)(b * 8 + h) * DV * SEQ;
    bf16x8 qf[NS];
    { const bf16* qp = Q + (size_t)(b * SEQ + qrow0 + l31) * PITCH + h * HD + kd0 + 8 * hi;
#pragma unroll
      for (int s = 0; s < NS; ++s) qf[s] = *(const bf16x8*)(qp + 16 * s); }
    if (MODE == 0) { LAS float* tab = (LAS float*)(lds + ATT_TAB_OFF); const float* rb = p.relb + ((size_t)i2 * 8 + h) * 513; for (int i = tid; i < 513; i += 512) tab[i] = rb[i] * LOG2E; }
    constexpr bool KFULL = (NKP % 512) == 0;
    int kgo[KPT], klo[KPT], vgo[VPT], vlo[VPT]; bool kok[KPT];
#pragma unroll
    for (int i = 0; i < KPT; ++i) { const int pc = tid + 512 * i; kok[i] = pc < NKP; const int key = pc / CPR, ch = pc % CPR; kgo[i] = key * PITCH + ch * 8; klo[i] = key * KROW + ch * 16; }
#pragma unroll
    for (int i = 0; i < VPT; ++i) { const int pc = tid + 512 * i, dv = pc >> 3, ch = pc & 7; vgo[i] = dv * SEQ + ch * 8; vlo[i] = KST + dv * VROW + ch * 16; }
    v4u kreg[KPT], vreg[VPT];
#define ATT_LOAD(j) do { _Pragma("unroll") for (int i = 0; i < KPT; ++i) if (KFULL || kok[i]) kreg[i] = *(const v4u*)(Kg + (size_t)(j) * 64 * PITCH + kgo[i]); \
        _Pragma("unroll") for (int i = 0; i < VPT; ++i) vreg[i] = *(const v4u*)(Vg + (j) * 64 + vgo[i]); } while (0)
#define ATT_WRITE(so) do { _Pragma("unroll") for (int i = 0; i < KPT; ++i) if (KFULL || kok[i]) *(LAS v4u*)(lds + (so) + klo[i]) = kreg[i]; \
        _Pragma("unroll") for (int i = 0; i < VPT; ++i) *(LAS v4u*)(lds + (so) + vlo[i]) = vreg[i]; } while (0)
    f32x16 o[NDV];
#pragma unroll
    for (int d = 0; d < NDV; ++d) o[d] = f32x16{};
    constexpr float ATT_THR = 8.f;
    float mrun = 0.f, lrun = 0.f; f32x16 negm = f32x16{};
    ATT_LOAD(jlo_u); ATT_WRITE(0);
    if (jlo_u < jhi_u) ATT_LOAD(jlo_u + 1);
    __syncthreads();
    int sb = 0;
    WItem cw; f32x4 cv[8]; float cg = 0.f, cls = 0.f; int cst = 0, cage = 0; cw.fp8 = 0;
    LAS float* ctl = (LAS float*)(lds + WCONV_LDS_OFF);
    static_assert(MODE == 2 || 3 * STAGE <= WCONV_LDS_OFF, "conversion tile above the K/V stages");
    for (int j = jlo_u; j <= jhi_u; ++j) {
        const int sb1 = (sb == 2 * STAGE) ? 0 : sb + STAGE;
        if (MODE != 2 && cvid >= 0) {
            if (cst == 2) { wconv_lds_read_store(cw, w, lane, ctl); cst = 0; }
            else if (cst == 1 && ++cage >= 2) { wconv_lds_write(cw, w, lane, cv, cg, cls, ctl); cst = 2; }
        }
        if (j < jhi_u) ATT_WRITE(sb1);
        if (j + 1 < jhi_u) ATT_LOAD(j + 2);
        if (MODE != 2 && cvid >= 0) {
            if (cst == 0 && cs.done < MOE_CONV_PER_WG && jhi_u - j >= 3 && cs.step >= cs.next) {
                cw = moe_conv_item(p, layer >> 1, cvid + 256 * cs.done); wconv_load(cw, w, lane, cv, cg, cls); cst = 1; cage = 0; ++cs.done; cs.next = cs.step + MOE_CONV_PERIOD; }
            ++cs.step; }
        if (j >= jlo_w && j <= jhi_w) {
            const LAS unsigned char* Kl = lds + sb; const LAS unsigned char* Vl = Kl + KST;
            f32x16 sa[2];
            { bf16x8 kf[2 * NS];
#pragma unroll
              for (int kh = 0; kh < 2; ++kh)
#pragma unroll
                for (int s = 0; s < NS; ++s) kf[kh * NS + s] = *(const LAS bf16x8*)(Kl + (32 * kh + l31) * KROW + (kd0 + 16 * s + 8 * hi) * 2);
#pragma unroll
              for (int kh = 0; kh < 2; ++kh)
#pragma unroll
                for (int s = 0; s < NS; ++s) sa[kh] = __builtin_amdgcn_mfma_f32_32x32x16_bf16(kf[kh * NS + s], qf[s], s == 0 ? negm : sa[kh], 0, 0, 0); }
            asm volatile("s_nop 15\n\ts_nop 7" : "+v"(sa[0]), "+v"(sa[1]));
            bf16x8 vf[8];
#pragma unroll
            for (int d = 0; d < 2; ++d)
#pragma unroll
                for (int ks = 0; ks < 4; ++ks) vf[d * 4 + ks] = *(const LAS bf16x8*)(Vl + (32 * d + l31) * VROW + (16 * ks + 8 * hi) * 2);
            if (MODE == 0) { const LAS float* tab = (const LAS float*)(lds + ATT_TAB_OFF); const int dc = cq - j;
                if (dc >= 5) { const float bv = tab[512];
#pragma unroll
                    for (int r = 0; r < 16; ++r) { sa[0][r] += bv; sa[1][r] += bv; } }
                else { const int rel0 = 64 * dc + 32 * (wq & 1) + l31 + 256;
#pragma unroll
                    for (int kh = 0; kh < 2; ++kh)
#pragma unroll
                        for (int r = 0; r < 16; ++r) { int idx = rel0 - (32 * kh + crow(r, hi)); idx = idx > 512 ? 512 : idx; sa[kh][r] += tab[idx]; } } }
            float mx = max3f(sa[0][0], sa[1][0], sa[0][1]), my = max3f(sa[1][1], sa[0][2], sa[1][2]);
#pragma unroll
            for (int r = 3; r < 15; r += 2) { mx = max3f(mx, sa[0][r], sa[1][r]); my = max3f(my, sa[0][r + 1], sa[1][r + 1]); }
            mx = max3f(mx, sa[0][15], sa[1][15]); mx = max3f(mx, my, my);
            mx = xhalf_max(mx);
            const bool first = (j == jlo_w);
            if (first || __any(mx > ATT_THR)) {
                const float dl = first ? mx : fmaxf(mx, 0.f);
                mrun += dl;
#pragma unroll
                for (int r = 0; r < 16; ++r) { sa[0][r] -= dl; sa[1][r] -= dl; negm[r] = -mrun; }
                if (!first) { const float alpha = __builtin_amdgcn_exp2f(-dl); lrun *= alpha;
#pragma unroll
                    for (int d = 0; d < NDV; ++d)
#pragma unroll
                        for (int r = 0; r < 16; ++r) o[d][r] *= alpha; }
            }
            float ls = 0.f;
#pragma unroll
            for (int kh = 0; kh < 2; ++kh)
#pragma unroll
                for (int r = 0; r < 16; ++r) { const float e = __builtin_amdgcn_exp2f(sa[kh][r]); sa[kh][r] = e; ls += e; }
            lrun += ls;
            bf16x8 pb[4];
#pragma unroll
            for (int ks = 0; ks < 4; ++ks) { const int kh = ks >> 1, r0 = 8 * (ks & 1); v4u t;
                t.x = pk2(sa[kh][r0 + 0], sa[kh][r0 + 1]); t.y = pk2(sa[kh][r0 + 2], sa[kh][r0 + 3]); t.z = pk2(sa[kh][r0 + 4], sa[kh][r0 + 5]); t.w = pk2(sa[kh][r0 + 6], sa[kh][r0 + 7]);
                pb[ks] = __builtin_bit_cast(bf16x8, t); }
            if (NDV == 4) { bf16x8 vg[8];
#pragma unroll
                for (int d = 0; d < 2; ++d)
#pragma unroll
                    for (int ks = 0; ks < 4; ++ks) vg[d * 4 + ks] = *(const LAS bf16x8*)(Vl + (32 * (d + 2) + l31) * VROW + (16 * ks + 8 * hi) * 2);
#pragma unroll
                for (int d = 0; d < 2; ++d)
#pragma unroll
                    for (int ks = 0; ks < 4; ++ks) o[d] = __builtin_amdgcn_mfma_f32_32x32x16_bf16(vf[d * 4 + ks], pb[ks], o[d], 0, 0, 0);
#pragma unroll
                for (int d = 0; d < 2; ++d)
#pragma unroll
                    for (int ks = 0; ks < 4; ++ks) o[NDV - 2 + d] = __builtin_amdgcn_mfma_f32_32x32x16_bf16(vg[d * 4 + ks], pb[ks], o[NDV - 2 + d], 0, 0, 0);
            } else {
#pragma unroll
                for (int d = 0; d < 2; ++d)
#pragma unroll
                    for (int ks = 0; ks < 4; ++ks) o[d] = __builtin_amdgcn_mfma_f32_32x32x16_bf16(vf[d * 4 + ks], pb[ks], o[d], 0, 0, 0);
            }
        }
        sb = sb1;
        __syncthreads();
    }
#undef ATT_LOAD
#undef ATT_WRITE
    const float linv = 1.f / xhalf_sum(lrun);
    const size_t tok = (size_t)b * SEQ + qrow0 + l31;
    if (MODE != 2) {
        bf16* orow = O + tok * 1024 + (MODE == 1 ? 512 : 0) + h * 64 + 8 * hi;
#pragma unroll
        for (int d = 0; d < NDV; ++d)
#pragma unroll
            for (int g = 0; g < 4; g += 2) {
                unsigned ax = pk2(o[d][4 * g] * linv, o[d][4 * g + 1] * linv), ay = pk2(o[d][4 * g + 2] * linv, o[d][4 * g + 3] * linv);
                unsigned bx = pk2(o[d][4 * g + 4] * linv, o[d][4 * g + 5] * linv), by = pk2(o[d][4 * g + 6] * linv, o[d][4 * g + 7] * linv);
                { auto r = __builtin_amdgcn_permlane32_swap(ax, bx, false, false); ax = r[0]; bx = r[1]; }
                { auto r = __builtin_amdgcn_permlane32_swap(ay, by, false, false); ay = r[0]; by = r[1]; }
                *(v4u*)(orow + 32 * d + 8 * g) = (v4u){ax, ay, bx, by}; }
    } else {
        LAS float* xch = (LAS float*)lds + (size_t)(w & 3) * 4096 + lane;
        if (w >= 4) {
#pragma unroll
            for (int d = 0; d < NDV; ++d)
#pragma unroll
                for (int r = 0; r < 16; ++r) xch[(d * 16 + r) * 64] = o[d][r] * linv;
        }
        __syncthreads();
        if (w < 4) {
            const float* sg = p.subln + i2 * 128 + 4 * hi; f32x4 gvv[NDV][4];
#pragma unroll
            for (int d = 0; d < NDV; ++d)
#pragma unroll
                for (int g = 0; g < 4; ++g) gvv[d][g] = *(const f32x4*)(sg + 32 * d + 8 * g);
            float ss = 0.f;
#pragma unroll
            for (int d = 0; d < NDV; ++d)
#pragma unroll
                for (int r = 0; r < 16; ++r) { const float v = o[d][r] * linv - lam * xch[(d * 16 + r) * 64]; o[d][r] = v; ss += v * v; }
            ss = xhalf_sum(ss);
            const float rs = (1.f - lam_init) / sqrtf(ss * (1.f / 128) + EPS);
            bf16* orow = O + tok * 1024 + h * 128 + 8 * hi;
#pragma unroll
            for (int d = 0; d < NDV; ++d)
#pragma unroll
                for (int g = 0; g < 4; g += 2) { const f32x4 ga = gvv[d][g], gb = gvv[d][g + 1];
                    unsigned ax = pk2(o[d][4 * g] * rs * ga.x, o[d][4 * g + 1] * rs * ga.y), ay = pk2(o[d][4 * g + 2] * rs * ga.z, o[d][4 * g + 3] * rs * ga.w);
                    unsigned bx = pk2(o[d][4 * g + 4] * rs * gb.x, o[d][4 * g + 5] * rs * gb.y), by = pk2(o[d][4 * g + 6] * rs * gb.z, o[d][4 * g + 7] * rs * gb.w);
                    { auto r = __builtin_amdgcn_permlane32_swap(ax, bx, false, false); ax = r[0]; bx = r[1]; }
                    { auto r = __builtin_amdgcn_permlane32_swap(ay, by, false, false); ay = r[0]; by = r[1]; }
                    *(v4u*)(orow + 32 * d + 8 * g) = (v4u){ax, ay, bx, by}; }
        }
        __syncthreads();
    }
}

template <int MODE>
__device__ __forceinline__ void attn_phase(const P& p, LAS unsigned char* lds, int layer, int vcu, int G, float lam_init, CvState& cs) {
    constexpr int NQB = MODE == 2 ? 32 : 16, NU = 64 * NQB;
    float lam = 0.f;
    if (MODE == 2) { const int lane = threadIdx.x & 63, i2 = layer >> 1;
        const float a1 = wave_sum(p.lq1[i2 * 64 + lane] * p.lk1[i2 * 64 + lane]), a2 = wave_sum(p.lq2[i2 * 64 + lane] * p.lk2[i2 * 64 + lane]);
        lam = expf(a1) - expf(a2) + lam_init; }
    const bool bal = (G == 256);
    const int nit = bal ? NQB / 4 : (NU - vcu + G - 1) / G;
#pragma unroll 1
    for (int i = 0; i < nit; ++i) {
        int bh, qb;
        if (bal) { const int s = vcu & 3; bh = vcu >> 2; qb = 4 * i + ((i & 1) ? 3 - s : s); } else { const int u = vcu + i * G; bh = u / NQB; qb = u % NQB; }
        attn_unit<MODE>(p, lds, layer, bh >> 3, bh & 7, qb, lam_init, lam, cs, (MODE != 2 && bal && MOE_FP8 && MOE_CONV_OVL) ? vcu : -1);
    }
}


__device__ __forceinline__ void moe_conv_rest(const P& p, LAS unsigned char* lds, int pr, int vcu, int G, CvState& cs) {
    if (G != 256 || !MOE_FP8 || !MOE_CONV_OVL) return;
    const int tid = threadIdx.x, lane = tid & 63, wave = __builtin_amdgcn_readfirstlane(tid >> 6);
    LAS float* tl = (LAS float*)(lds + WCONV_LDS_OFF);
    for (; cs.done < MOE_CONV_PER_WG; ++cs.done) { const WItem w = moe_conv_item(p, pr, vcu + 256 * cs.done); f32x4 v[8]; float g, ls; wconv_load(w, wave, lane, v, g, ls); wconv_store(w, wave, lane, v, g, ls, tl); }
}

#define XB_TMO      128
#define XB_XCNT(j)  (256  + 64 * (j))
#define XB_XSUB(j)  (1280 + 64 * (j))
#define XB_XGEN(j)  (2304 + 64 * (j))
#define XB_TOP      3328
#define XB_TOPGEN   3392
#define XCD_BAR_WORDS 3456
#define XB_SPIN_CAP (1u << 18)

__device__ __forceinline__ unsigned xb_ld(unsigned* p)              { return __hip_atomic_load(p, __ATOMIC_RELAXED, __HIP_MEMORY_SCOPE_AGENT); }
__device__ __forceinline__ unsigned xb_add(unsigned* p, unsigned v) { return __hip_atomic_fetch_add(p, v, __ATOMIC_RELAXED, __HIP_MEMORY_SCOPE_AGENT); }
__device__ __forceinline__ unsigned xb_xcc_id() { return (unsigned)__builtin_amdgcn_s_getreg((3 << 11) | 20) & 0xFu; }
#define XB_SPIN(cond, bar) do { unsigned _sp = 0; while (cond) { __builtin_amdgcn_s_sleep(1); \
    if ((++_sp & 255u) == 0u) { if (xb_ld(&(bar)[XB_TMO])) break; if (_sp > XB_SPIN_CAP) { atomicAdd(&(bar)[XB_TMO], 1u); break; } } } } while (0)

struct XcdBarrier {
    unsigned* bar; unsigned x;
    volatile LAS unsigned* st;
};

__device__ __forceinline__ XcdBarrier xcd_barrier_post(unsigned* bar, volatile LAS unsigned* st) {
    XcdBarrier b; b.bar = bar; b.x = xb_xcc_id(); b.st = st;
    if (threadIdx.x == 0) (void)xb_add(&bar[XB_XCNT(b.x)], 1u);
    return b;
}
__device__ __forceinline__ void xcd_barrier_complete(unsigned* bar, unsigned x, unsigned& nloc, unsigned& nx) {
    const unsigned G = gridDim.x * gridDim.y * gridDim.z;
    unsigned sum, cnt, mine, sp = 0u;
    for (;;) {
        sum = 0u; cnt = 0u; mine = 0u;
#pragma unroll
        for (unsigned j = 0; j < 16; ++j) { const unsigned c = xb_ld(&bar[XB_XCNT(j)]); sum += c; cnt += (c > 0u) ? 1u : 0u; mine = (j == x) ? c : mine; }
        if (sum == G) break;
        __builtin_amdgcn_s_sleep(1);
        if ((++sp & 255u) == 0u) { if (xb_ld(&bar[XB_TMO])) break; if (sp > XB_SPIN_CAP) { atomicAdd(&bar[XB_TMO], 1u); break; } }
    }
    nloc = mine > 0u ? mine : 1u; nx = cnt > 0u ? cnt : 1u;
}

__device__ __forceinline__ void xcd_barrier(const XcdBarrier& b) {
    asm volatile("s_waitcnt vmcnt(0)" ::: "memory");
    __syncthreads();
    if (threadIdx.x == 0) {
        unsigned* bar = b.bar;
        __builtin_amdgcn_s_waitcnt(0);
        unsigned nloc = b.st[0], nx = b.st[1];
        if (nloc == 0u) { xcd_barrier_complete(bar, b.x, nloc, nx); b.st[0] = nloc; b.st[1] = nx; }
        const unsigned old = xb_add(&bar[XB_XSUB(b.x)], 1u);
        const unsigned gen = old / nloc;
        if (old + 1u == (gen + 1u) * nloc) {
            __builtin_amdgcn_fence(__ATOMIC_RELEASE, "agent");
            asm volatile("s_waitcnt vmcnt(0)" ::: "memory");
            const unsigned og = xb_add(&bar[XB_TOP], 1u);
            const unsigned tg = og / nx;
            if (og + 1u == (tg + 1u) * nx) xb_add(&bar[XB_TOPGEN], 1u);
            else XB_SPIN(xb_ld(&bar[XB_TOPGEN]) == tg, bar);
            __builtin_amdgcn_fence(__ATOMIC_ACQUIRE, "agent");
            xb_add(&bar[XB_XGEN(b.x)], 1u);
            asm volatile("s_waitcnt vmcnt(0)" ::: "memory");
        } else {
            XB_SPIN(xb_ld(&bar[XB_XGEN(b.x)]) == gen, bar);
            __builtin_amdgcn_fence(__ATOMIC_ACQUIRE, "agent");
            asm volatile("s_waitcnt vmcnt(0)" ::: "memory");
        }
    }
    __syncthreads();
}


constexpr int NPHASE = 29;
struct Args { P p; int ph_lo, ph_hi; };
#define CAS __attribute__((address_space(4)))
#if defined(__HIP_DEVICE_COMPILE__)
__device__ __forceinline__ const CAS Args* kargs() { const CAS Args* q = (const CAS Args*)__builtin_amdgcn_kernarg_segment_ptr(); asm volatile("" : "+s"(q)); return q; }
#else
__device__ const Args* kargs();
#endif
#ifndef PHASE_MASK
#define PHASE_MASK 0x7fff
#endif
#define PHEN(t) (((PHASE_MASK) >> (t)) & 1)
#define IN(k) (lo <= (k) && (k) < hi)
#define SEAM(k) do { if (IN(k) && IN((k) + 1)) xcd_barrier(bar); } while (0)
#define PH_ENV const P p = kargs()->p; unsigned char* ws = p.ws; unsigned char* ar = ws + WS_AR; unsigned char* wb = ws + WS_W; \
    const bf16* HB = (const bf16*)(ws + WS_HB); float* H = (float*)(ws + WS_H); float* SSQ = (float*)(ws + WS_SSQ); \
    const int* SEG = (const int*)(ws + WS_META); (void)ar; (void)wb; (void)HB; (void)H; (void)SSQ; (void)SEG;
template <int pr>
__device__ __forceinline__ void layer_pair(LAS unsigned char* lds, const int lo, const int hi, const XcdBarrier& bar, const int bid, const int G, const int vcu) {
        const int base = 1 + 14 * pr, le = 2 * pr, lod = 2 * pr + 1;
        if (PHEN(0) && IN(base + 0)) { PH_ENV
            pg8::Gemm g{ws, (unsigned)WS_HB, (unsigned)(WS_W + WO_IN_E) + (unsigned)pr * 2048u * 1024u * 2u, 2048, 1024}; pg8::StaticOrder S; S.init(T, 2048, G, bid, nullptr);
            EpiEvenIn E{ws, lds, p.pos};
            pg8::gemm_phase(lds, g, S, E); SEAM(base + 0);
        }
        if (PHEN(1) && IN(base + 1)) { PH_ENV
            { pg8::Gemm g{ws, OA(AR_CQ), (unsigned)(WS_W + WO_UQ) + (unsigned)pr * 768u * 256u * 2u, 768, 256}; pg8::StaticOrder S; S.init(T, 768, G, bid, nullptr);
              EpiUq E{ws, p.pos}; pg8::gemm_phase(lds, g, S, E); }
            { pg8::Gemm g{ws, OA(AR_CKV), (unsigned)(WS_W + WO_UKV) + (unsigned)pr * 1024u * 256u * 2u, 1024, 256}; pg8::StaticOrder S; S.init(T, 1024, G, bid, nullptr);
              EpiUkv E{ws, lds}; pg8::gemm_phase(lds, g, S, E); }
            SEAM(base + 1);
        }
        if (PHEN(2) && IN(base + 2)) { PH_ENV CvState cs{0, 0, vcu % MOE_CONV_PERIOD}; attn_phase<0>(p, lds, le, vcu, G, 0.f, cs); attn_phase<1>(p, lds, le, vcu, G, 0.f, cs); moe_conv_rest(p, lds, pr, vcu, G, cs); SEAM(base + 2); }
        if (PHEN(3) && IN(base + 3)) { PH_ENV
            pg8::Gemm g{ws, OA(AR_MIX), (unsigned)(WS_W + WO_OUT_E) + (unsigned)pr * 1024u * 1024u * 2u, 1024, 1024}; pg8::StaticOrder S; S.init(T, 1024, G, bid, nullptr);
            EpiRes<((FFN8_GU >> pr) & 1) != 0> E{ws, pr == 0 ? p.x : (const float*)H, 1.f}; pg8::gemm_phase(lds, g, S, E); SEAM(base + 3);
        }
        if (PHEN(4) && IN(base + 4)) { PH_ENV
            constexpr bool A8 = ((FFN8_DN >> pr) & 1) != 0;
            if constexpr (((FFN8_GU >> pr) & 1) != 0) {
                pg8::Gemm g{ws, OA(AR_HB8), (unsigned)(WS_W + WO_GU_D) + (unsigned)pr * 5632u * 1024u * 2u, 5632, 1024}; pg8::StaticOrder S; S.init(T, 5632, G, bid, nullptr);
                EpiSwigluX<true, true, A8> E{ws, OA(AR_ACT), FFD}; pg8::gemm_phase<EpiSwigluX<true, true, A8>, pg8::StaticOrder, true>(lds, g, S, E);
            } else {
                pg8::Gemm g{ws, (unsigned)WS_HB, (unsigned)(WS_W + WO_GU_D) + (unsigned)pr * 5632u * 1024u * 2u, 5632, 1024}; pg8::StaticOrder S; S.init(T, 5632, G, bid, nullptr);
                EpiSwigluX<true, false, A8> E{ws, OA(AR_ACT), FFD}; pg8::gemm_phase(lds, g, S, E);
            }
            SEAM(base + 4);
        }
        if (PHEN(5) && IN(base + 5)) { PH_ENV
            if constexpr (((FFN8_DN >> pr) & 1) != 0) {
                pg8::Gemm g{ws, OA(AR_ACT), (unsigned)(WS_W + WO_DN_D) + (unsigned)pr * 1024u * 2816u * 2u, 1024, 2816}; pg8::StaticOrder S; S.init(T, 1024, G, bid, nullptr);
                EpiRes<false> E{ws, (const float*)H, 1.f / (FP8_AS * FP8_WS_DN)}; pg8::gemm_phase<EpiRes<false>, pg8::StaticOrder, true>(lds, g, S, E);
            } else {
                pg8::Gemm g{ws, OA(AR_ACT), (unsigned)(WS_W + WO_DN_D) + (unsigned)pr * 1024u * 2816u * 2u, 1024, 2816}; pg8::StaticOrder S; S.init(T, 1024, G, bid, nullptr);
                EpiRes<false> E{ws, (const float*)H, 1.f}; pg8::gemm_phase(lds, g, S, E);
            }
            SEAM(base + 5);
        }
        if (PHEN(6) && IN(base + 6)) { PH_ENV
            pg8::Gemm g{ws, (unsigned)WS_HB, (unsigned)(WS_W + WO_IN_O) + (unsigned)pr * 3072u * 1024u * 2u, 3072, 1024}; pg8::StaticOrder S; S.init(T, 3072, G, bid, nullptr);
            EpiOddIn E{ws, lds, p.pos}; pg8::gemm_phase(lds, g, S, E); SEAM(base + 6);
        }
        if (PHEN(7) && IN(base + 7)) { PH_ENV CvState cs{0, 0, 0}; attn_phase<2>(p, lds, lod, vcu, G, pr == 0 ? 0.35550906759096934f : 0.5560582041556406f, cs); SEAM(base + 7); }
        if (PHEN(8) && IN(base + 8)) { PH_ENV
            pg8::Gemm g{ws, OA(AR_MIX), (unsigned)(WS_W + WO_OUT_O) + (unsigned)pr * 1024u * 1024u * 2u, 1024, 1024}; pg8::StaticOrder S; S.init(T, 1024, G, bid, nullptr);
            EpiRes<false, false> E{ws, (const float*)H, 1.f}; pg8::gemm_phase(lds, g, S, E); SEAM(base + 8);
        }
        if (PHEN(9) && IN(base + 9)) { PH_ENV ph_route(p, lod, bid, G, (LAS int*)lds); SEAM(base + 9); }
        if (PHEN(10) && IN(base + 10)) { PH_ENV ph_gather(p, bid, G, (LAS int*)lds); SEAM(base + 10); }
        if (PHEN(11) && IN(base + 11)) { PH_ENV
#if MOE_FP8
            pg8::Gemm g{ws, OA(AR_XG), (unsigned)(WS_W + WO_GU_M) + (unsigned)pr * 8u * 7168u * 1024u, 7168, 1024}; pg8::StaticOrder S; S.init(0, 7168, G, bid, SEG);
            EpiSwigluFp8<false> E{ws, OA(AR_ACTM), FFE}; pg8::gemm_phase<EpiSwigluFp8<false>, pg8::StaticOrder, true>(lds, g, S, E); SEAM(base + 11);
#else
            pg8::Gemm g{ws, OA(AR_XG), (unsigned)(WS_W + WO_GU_M) + (unsigned)pr * 8u * 7168u * 1024u * 2u, 7168, 1024}; pg8::StaticOrder S; S.init(0, 7168, G, bid, SEG);
            EpiSwiglu<false> E{ws, OA(AR_ACTM), FFE}; pg8::gemm_phase(lds, g, S, E); SEAM(base + 11);
#endif
        }
        if (PHEN(12) && IN(base + 12)) { PH_ENV
#if MOE_FP8
            pg8::Gemm g{ws, OA(AR_ACTM), (unsigned)(WS_W + WO_DN_M) + (unsigned)pr * 8u * 1024u * 3584u, 1024, 3584}; pg8::StaticOrder S; S.init(0, 1024, G, bid, SEG);
            EpiMoeDown E{ws, 1.f / (FP8_AS * FP8_WS_DN)}; pg8::gemm_phase<EpiMoeDown, pg8::StaticOrder, true>(lds, g, S, E); SEAM(base + 12);
#else
            pg8::Gemm g{ws, OA(AR_ACTM), (unsigned)(WS_W + WO_DN_M) + (unsigned)pr * 8u * 1024u * 3584u * 2u, 1024, 3584}; pg8::StaticOrder S; S.init(0, 1024, G, bid, SEG);
            EpiMoeDown E{ws, 1.f}; pg8::gemm_phase(lds, g, S, E); SEAM(base + 12);
#endif
        }
        if (PHEN(13) && IN(base + 13)) { PH_ENV ph_combine(p, pr == 1, bid, G); SEAM(base + 13); }
}
__global__ void __launch_bounds__(NWAVES * 64, 2) mega(Args args) {
    extern __shared__ __attribute__((aligned(16))) unsigned char lds_raw[];
    LAS unsigned char* lds = (LAS unsigned char*)lds_raw;
    const int tid = threadIdx.x, G = gridDim.x, bid = blockIdx.x;
    const int vcu = (G % 8 == 0) ? (bid % 8) * (G / 8) + bid / 8 : bid;
    volatile LAS unsigned* MISC = (volatile LAS unsigned*)(lds + LDSCTL_OFF);
    for (int u = tid; u < 128; u += NWAVES * 64) MISC[u] = 0u;
    __syncthreads();
    const int lo = kargs()->ph_lo, hi = kargs()->ph_hi;
    unsigned* const barw = (unsigned*)(kargs()->p.ws + WS_CTL) + CW_BAR;
    XcdBarrier bar; bar.bar = barw; bar.x = 0; bar.st = nullptr;
    if (hi - lo > 1) bar = xcd_barrier_post(barw, MISC + 8);

    if (PHEN(14) && IN(0)) { PH_ENV ph_wconv(p, lds, bid, G); ph_prologue(p, bid, G); SEAM(0); }
    layer_pair<0>(lds, lo, hi, bar, bid, G, vcu);
    layer_pair<1>(lds, lo, hi, bar, bid, G, vcu);
#undef IN
#undef SEAM
#undef PH_ENV
}


extern "C" void kernel_launch(void* const* d_in, const int* in_sizes, int n_in, void* d_out, int out_size, void* d_ws, size_t ws_size, hipStream_t stream) {
    static int grid = 0;
    if (grid == 0) {
        if (n_in != 24 || ws_size < WS_TMP) fprintf(stderr, "kernel_launch: unexpected n_in %d or ws_size %zu (need %zu)\n", n_in, ws_size, (size_t)WS_TMP);
        int dev = 0, cus = 0, per_cu = 0;
        if (hipGetDevice(&dev) != hipSuccess || hipDeviceGetAttribute(&cus, hipDeviceAttributeMultiprocessorCount, dev) != hipSuccess) { fprintf(stderr, "kernel_launch: device query failed\n"); grid = -1; return; }
        if (hipFuncSetAttribute((const void*)mega, hipFuncAttributeMaxDynamicSharedMemorySize, LDS_BYTES) != hipSuccess) { fprintf(stderr, "kernel_launch: hipFuncSetAttribute failed\n"); grid = -1; return; }
        if (hipOccupancyMaxActiveBlocksPerMultiprocessor(&per_cu, (const void*)mega, NWAVES * 64, LDS_BYTES) != hipSuccess || per_cu < 1) fprintf(stderr, "kernel_launch: occupancy query reports %d blocks per CU\n", per_cu);
        (void)hipGetLastError();
        grid = cus;
    }
    if (grid < 0) return;
    Args a{};
    P& p = a.p;
    p.x = (const float*)d_in[0]; p.pos = (const int*)d_in[1]; p.mix_g = (const float*)d_in[2]; p.ffn_g = (const float*)d_in[3]; p.w_in_e = (const float*)d_in[4]; p.relb = (const float*)d_in[5];
    p.qn_g = (const float*)d_in[6]; p.w_uq = (const float*)d_in[7]; p.kvn_g = (const float*)d_in[8]; p.w_ukv = (const float*)d_in[9]; p.w_out_e = (const float*)d_in[10]; p.w_in_o = (const float*)d_in[11];
    p.lq1 = (const float*)d_in[12]; p.lk1 = (const float*)d_in[13]; p.lq2 = (const float*)d_in[14]; p.lk2 = (const float*)d_in[15]; p.subln = (const float*)d_in[16]; p.w_out_o = (const float*)d_in[17];
    p.w_gu_d = (const float*)d_in[18]; p.w_dn_d = (const float*)d_in[19]; p.w_rt = (const float*)d_in[20]; p.w_gu_m = (const float*)d_in[21]; p.w_dn_m = (const float*)d_in[22]; p.fin_g = (const float*)d_in[23];
    p.out = (float*)d_out; p.ws = (unsigned char*)d_ws;
    (void)hipMemsetAsync((unsigned char*)d_ws + WS_CTL, 0, 65536, stream);
#if ONE_LAUNCH
    a.ph_lo = 0; a.ph_hi = NPHASE;
    hipLaunchKernelGGL(mega, dim3(grid), dim3(NWAVES * 64), LDS_BYTES, stream, a);
#else
    for (int k = 0; k < NPHASE; ++k) {
        a.ph_lo = k; a.ph_hi = k + 1;
        hipLaunchKernelGGL(mega, dim3(grid), dim3(NWAVES * 64), LDS_BYTES, stream, a);
#if defined(DUP_MASK)
        if ((DUP_MASK >> (k == 0 ? 14 : (k - 1) % 14)) & 1) for (int r = 0; r < DUP_N; ++r) hipLaunchKernelGGL(mega, dim3(grid), dim3(NWAVES * 64), LDS_BYTES, stream, a);
#endif
    }
#endif
    const hipError_t le = hipPeekAtLastError();
    if (le != hipSuccess) fprintf(stderr, "kernel_launch: launch failed: %s\n", hipGetErrorName(le));
}
```

```cpp
#include <hip/hip_runtime.h>
#include <stdint.h>
#include <stdio.h>
#include <cmath>
#define MOE_CONV_OVL 0
#ifndef ONE_LAUNCH
#define ONE_LAUNCH 1
#endif

constexpr int NB = 8, SEQ = 4096, T = NB * SEQ, D = 1024;
constexpr float EPS = 1e-6f;
constexpr float LOG2E = 1.4426950408889634f;
constexpr int FFD = 2816, FFE = 3584, NEXP = 8;
constexpr int NSLOT = 2 * T + NEXP * 256;
constexpr int EIN = 1952;
constexpr int NCHUNK_R = 256, RCH = 128;

typedef unsigned short bf16;
typedef unsigned v4u __attribute__((ext_vector_type(4)));
typedef unsigned v2u __attribute__((ext_vector_type(2)));
typedef float f32x4 __attribute__((ext_vector_type(4)));

constexpr size_t MiB = 1u << 20;
constexpr size_t WS_CTL = 0;
constexpr size_t WS_META = 1 * MiB;
constexpr size_t WS_SSQ = 14 * MiB;
constexpr size_t WS_SSQQ = 16 * MiB;
constexpr size_t WS_SSQKV = 16 * MiB + 512 * 1024;
constexpr size_t WS_TOPE = 17 * MiB;
constexpr size_t WS_TOPG = WS_TOPE + 256 * 1024;
constexpr size_t WS_LRANK = WS_TOPG + 256 * 1024;
constexpr size_t WS_SLOT = WS_LRANK + 256 * 1024;
constexpr size_t WS_TOKI = 18 * MiB;
constexpr size_t WS_GATE = WS_TOKI + 512 * 1024;
constexpr size_t WS_H = 20 * MiB;
constexpr size_t WS_HB = 148 * MiB;
constexpr size_t WS_W = 212 * MiB;
constexpr size_t WS_AR = 612 * MiB;
constexpr size_t WS_TMP = 1340 * MiB;
constexpr size_t WS_END = 1724 * MiB;
constexpr size_t AR_QA = 0, AR_KA = 32 * MiB, AR_VAT = 64 * MiB, AR_CQ = 96 * MiB, AR_CKV = 112 * MiB  , AR_QB = 128 * MiB, AR_KB = 176 * MiB, AR_VBT = 224 * MiB, AR_MIX = 256 * MiB;
constexpr size_t AR_ACT = 0;
constexpr size_t AR_HB8 = 192 * MiB;
constexpr size_t AR_QC = 0, AR_KC = 64 * MiB, AR_VCT = 128 * MiB;
constexpr size_t AR_XG = 0, AR_HN = 68 * MiB  , AR_ACTM = 136 * MiB, AR_Y = 598 * MiB;

typedef float f32x2_t __attribute__((ext_vector_type(2))); typedef __bf16 bf16x2_t __attribute__((ext_vector_type(2)));
__device__ __forceinline__ unsigned pk2(float lo, float hi) { const f32x2_t v = {lo, hi}; const bf16x2_t b = __builtin_convertvector(v, bf16x2_t); return __builtin_bit_cast(unsigned, b); }
__device__ __forceinline__ unsigned f2bf(float f) { return pk2(f, 0.f) & 0xffffu; }
__device__ __forceinline__ float bf2f(unsigned b) { return __builtin_bit_cast(float, b << 16); }
__device__ __forceinline__ float wave_sum(float v) {
#pragma unroll
    for (int o = 1; o < 64; o <<= 1) v += __shfl_xor(v, o);
    return v;
}
__device__ __forceinline__ float wave_max(float v) {
#pragma unroll
    for (int o = 1; o < 64; o <<= 1) v = fmaxf(v, __shfl_xor(v, o));
    return v;
}
__host__ __device__ __forceinline__ int permk(int s) { return (s & ~12) | ((s & 4) << 1) | ((s & 8) >> 1); }

struct P {
    const float* x; const int* pos; const float* mix_g; const float* ffn_g; const float* w_in_e; const float* relb; const float* qn_g; const float* w_uq;
    const float* kvn_g; const float* w_ukv; const float* w_out_e; const float* w_in_o; const float* lq1; const float* lk1; const float* lq2; const float* lk2;
    const float* subln; const float* w_out_o; const float* w_gu_d; const float* w_dn_d; const float* w_rt; const float* w_gu_m; const float* w_dn_m; const float* fin_g;
    float* out; unsigned char* ws;
    int layer, last;
};

#ifndef MOE_FP8
#define MOE_FP8 1
#endif
#ifndef H_BF16
#define H_BF16 1
#endif
#ifndef FFN8_GU
#define FFN8_GU 2
#endif
#ifndef FFN8_DN
#define FFN8_DN 2
#endif
#ifndef FFN_FP8
#define FFN_FP8 0
#endif
__device__ __forceinline__ unsigned pk4_fp8x(float a, float b, float c, float d) {
    int w = __builtin_amdgcn_cvt_pk_fp8_f32(__builtin_amdgcn_fmed3f(a, -448.f, 448.f), __builtin_amdgcn_fmed3f(b, -448.f, 448.f), 0, false);
    w = __builtin_amdgcn_cvt_pk_fp8_f32(__builtin_amdgcn_fmed3f(c, -448.f, 448.f), __builtin_amdgcn_fmed3f(d, -448.f, 448.f), w, true); return (unsigned)w; }
__device__ __forceinline__ void ph_prologue(const P& p, int bid, int nblk) {
    const int tid = threadIdx.x, nth = blockDim.x, lane = tid & 63, wave = tid >> 6, nw = nth >> 6;
    bf16* HB = (bf16*)(p.ws + WS_HB); float* SSQ = (float*)(p.ws + WS_SSQ);
    const int stride = nblk * nw; int row = bid * nw + wave;
    f32x4 v[4];
    if (row < T) { const f32x4* xr = (const f32x4*)(p.x + (size_t)row * D) + lane;
#pragma unroll
        for (int j = 0; j < 4; ++j) v[j] = xr[64 * j]; }
    for (; row < T; row += stride) {
        f32x4 vn[4];
        { const int rn = row + stride < T ? row + stride : row; const f32x4* xr = (const f32x4*)(p.x + (size_t)rn * D) + lane;
#pragma unroll
          for (int j = 0; j < 4; ++j) vn[j] = xr[64 * j]; }
        float s = 0.f;
#pragma unroll
        for (int j = 0; j < 4; ++j) s += v[j].x * v[j].x + v[j].y * v[j].y + v[j].z * v[j].z + v[j].w * v[j].w;
        s = wave_sum(s);
        v2u* o = (v2u*)(HB + (size_t)row * D) + lane;
#pragma unroll
        for (int j = 0; j < 4; ++j) { v2u w; w.x = pk2(v[j].x, v[j].y); w.y = pk2(v[j].z, v[j].w); o[64 * j] = w; }
        if (lane < 16) SSQ[row * 16 + lane] = lane == 0 ? s : 0.f;
#pragma unroll
        for (int j = 0; j < 4; ++j) v[j] = vn[j];
    }
}

template <class IP> __device__ __forceinline__ void ph_route(const P& p, int layer, int bid, int nblk, IP se  ) {
    const int tid = threadIdx.x, nth = blockDim.x, lane = tid & 63, wave = tid >> 6, nw = nth >> 6;
    const int i2 = layer >> 1;
    const float* H = (const float*)(p.ws + WS_H); bf16* HB = (bf16*)(p.ws + WS_HB); (void)H;
    bf16* HNo = H_BF16 ? (bf16*)(p.ws + WS_AR + AR_HN) : HB;
    const float* g = p.ffn_g + layer * D; const float* wr = p.w_rt + (size_t)i2 * D * 8;
    int* TOPE = (int*)(p.ws + WS_TOPE); float* TOPG = (float*)(p.ws + WS_TOPG); int* LRANK = (int*)(p.ws + WS_LRANK); int* CNT = (int*)(p.ws + WS_META + 4096);
    float wg[16][8];
#pragma unroll
    for (int j = 0; j < 4; ++j)
#pragma unroll
        for (int q = 0; q < 4; ++q) { const int k = lane * 4 + 256 * j + q; const float gk = g[k];
            const f32x4 w0 = *(const f32x4*)(wr + (size_t)k * 8), w1 = *(const f32x4*)(wr + (size_t)k * 8 + 4);
            wg[4 * j + q][0] = w0.x * gk; wg[4 * j + q][1] = w0.y * gk; wg[4 * j + q][2] = w0.z * gk; wg[4 * j + q][3] = w0.w * gk;
            wg[4 * j + q][4] = w1.x * gk; wg[4 * j + q][5] = w1.y * gk; wg[4 * j + q][6] = w1.z * gk; wg[4 * j + q][7] = w1.w * gk; }
    const bool b5 = lane & 32, b4 = lane & 16, b3 = lane & 8;
    for (int ch = bid; ch < NCHUNK_R; ch += nblk) {
#if H_BF16
#define RT_LOAD(V, tk) do { const v2u* hr_ = (const v2u*)(HB + (size_t)(tk) * D) + lane; _Pragma("unroll") for (int j = 0; j < 4; ++j) { const v2u t_ = hr_[64 * j]; \
        V[j].x = bf2f(t_.x & 0xffffu); V[j].y = bf2f(t_.x >> 16); V[j].z = bf2f(t_.y & 0xffffu); V[j].w = bf2f(t_.y >> 16); } } while (0)
#else
#define RT_LOAD(V, tk) do { const f32x4* hr_ = (const f32x4*)(H + (size_t)(tk) * D) + lane; _Pragma("unroll") for (int j = 0; j < 4; ++j) V[j] = hr_[64 * j]; } while (0)
#endif
        f32x4 v[4];
        RT_LOAD(v, ch * RCH + wave);
        for (int i = wave; i < RCH; i += nw) {
            const int tok = ch * RCH + i;
            f32x4 vn[4];
            { const int tn = (i + nw < RCH) ? tok + nw : tok; RT_LOAD(vn, tn); }
            float s = 0.f;
#pragma unroll
            for (int j = 0; j < 4; ++j) s += v[j].x * v[j].x + v[j].y * v[j].y + v[j].z * v[j].z + v[j].w * v[j].w;
            s = wave_sum(s);
            const float rstd = 1.0f / sqrtf(s * (1.f / D) + EPS);
            float lg[8];
#pragma unroll
            for (int e = 0; e < 8; ++e) lg[e] = 0.f;
            v2u* o = (v2u*)(HNo + (size_t)tok * D) + lane;
#pragma unroll
            for (int j = 0; j < 4; ++j) {
                const float hn[4] = {v[j].x * rstd, v[j].y * rstd, v[j].z * rstd, v[j].w * rstd};
                v2u w; w.x = pk2(hn[0], hn[1]); w.y = pk2(hn[2], hn[3]); o[64 * j] = w;
#pragma unroll
                for (int q = 0; q < 4; ++q)
#pragma unroll
                    for (int e = 0; e < 8; ++e) lg[e] += hn[q] * wg[4 * j + q][e];
            }
            float a4[4], a2[2];
#pragma unroll
            for (int e = 0; e < 4; ++e) { const float keep = b5 ? lg[e + 4] : lg[e], send = b5 ? lg[e] : lg[e + 4]; a4[e] = keep + __shfl_xor(send, 32); }
#pragma unroll
            for (int e = 0; e < 2; ++e) { const float keep = b4 ? a4[e + 2] : a4[e], send = b4 ? a4[e] : a4[e + 2]; a2[e] = keep + __shfl_xor(send, 16); }
            float c1; { const float keep = b3 ? a2[1] : a2[0], send = b3 ? a2[0] : a2[1]; c1 = keep + __shfl_xor(send, 8); }
            c1 += __shfl_xor(c1, 4); c1 += __shfl_xor(c1, 2); c1 += __shfl_xor(c1, 1);
            float lt[8];
#pragma unroll
            for (int e = 0; e < 8; ++e) lt[e] = __uint_as_float(__builtin_amdgcn_readlane(__float_as_uint(c1), 32 * (e >> 2) + 16 * ((e >> 1) & 1) + 8 * (e & 1)));
            int e1 = 0; float v1 = lt[0];
#pragma unroll
            for (int e = 1; e < 8; ++e) if (lt[e] > v1) { v1 = lt[e]; e1 = e; }
            int e2 = -1; float v2 = -INFINITY;
#pragma unroll
            for (int e = 0; e < 8; ++e) if (e != e1 && lt[e] > v2) { v2 = lt[e]; e2 = e; }
            const float g1 = 1.f / (1.f + expf(v2 - v1));
            if (lane == 0) { se[2 * i] = e1; se[2 * i + 1] = e2; TOPE[tok * 2] = e1; TOPE[tok * 2 + 1] = e2; TOPG[tok * 2] = g1; TOPG[tok * 2 + 1] = 1.f - g1; }
#pragma unroll
            for (int j = 0; j < 4; ++j) v[j] = vn[j];
        }
        __syncthreads();
        IP wcnt = se + 256;
        int myr = 0, mye = 0;
        if (wave < 4) { mye = se[64 * wave + lane];
#pragma unroll
            for (int e = 0; e < 8; ++e) { const unsigned long long m = __ballot(mye == e); if (mye == e) myr = __popcll(m & ((1ull << lane) - 1ull)); if (lane == 0) wcnt[wave * 8 + e] = __popcll(m); } }
        __syncthreads();
        if (wave < 4) { for (int w2 = 0; w2 < wave; ++w2) myr += wcnt[w2 * 8 + mye]; LRANK[ch * 256 + 64 * wave + lane] = myr; }
        if (tid < 8) CNT[ch * 8 + tid] = wcnt[tid] + wcnt[8 + tid] + wcnt[16 + tid] + wcnt[24 + tid];
        __syncthreads();
    }
}

template <class IP> __device__ __forceinline__ void ph_gather(const P& p, int bid, int nblk, IP base  ) {
    const int tid = threadIdx.x, nth = blockDim.x, lane = tid & 63, wave = tid >> 6, nw = nth >> 6;
    const int* CNT = (const int*)(p.ws + WS_META + 4096); int* META = (int*)(p.ws + WS_META);
    IP seg = base + 2048; IP tot = base + 2048 + 16;
    for (int i = tid; i < 2048; i += nth) base[i] = CNT[i];
    __syncthreads();
    if (wave < 8) {
        const int e = wave; int c[4], t = 0;
#pragma unroll
        for (int i = 0; i < 4; ++i) { c[i] = base[(4 * lane + i) * 8 + e]; t += c[i]; }
        int inc = t;
#pragma unroll
        for (int d = 1; d < 64; d <<= 1) { const int u = __shfl_up(inc, d); if (lane >= d) inc += u; }
        int run = inc - t;
#pragma unroll
        for (int i = 0; i < 4; ++i) { base[(4 * lane + i) * 8 + e] = run; run += c[i]; }
        if (lane == 63) tot[e] = inc;
    }
    __syncthreads();
    if (tid == 0) { int s = 0; for (int e = 0; e < 8; ++e) { seg[e] = s; s += (tot[e] + 255) & ~255; } seg[8] = s; }
    __syncthreads();
    if (bid == 0 && tid < 9) META[tid] = seg[tid];
    if (bid == 0 && tid < 8) META[16 + tid] = tot[tid];
    const int* TOPE = (const int*)(p.ws + WS_TOPE); const float* TOPG = (const float*)(p.ws + WS_TOPG); const int* LRANK = (const int*)(p.ws + WS_LRANK);
    int* SLOT = (int*)(p.ws + WS_SLOT); int* TOKI = (int*)(p.ws + WS_TOKI); float* GATE = (float*)(p.ws + WS_GATE);
    const bf16* HB = H_BF16 ? (const bf16*)(p.ws + WS_AR + AR_HN) : (const bf16*)(p.ws + WS_HB); bf16* XG = (bf16*)(p.ws + WS_AR + AR_XG);
    IP lslot = base + 2048 + 32;
    for (int ch = bid; ch < NCHUNK_R; ch += nblk) {
        if (tid < 256) { const int ent = ch * 256 + tid; const int e = TOPE[ent]; const int slot = seg[e] + base[ch * 8 + e] + LRANK[ent];
            SLOT[ent] = slot; TOKI[slot] = ent; GATE[slot] = TOPG[ent]; lslot[tid] = slot; }
        __syncthreads();
#pragma unroll 4
        for (int j = wave; j < 256; j += nw) {
            const int tok = (ch * 256 + j) >> 1; const int slot = lslot[j];
#if MOE_FP8
            const v4u* src = (const v4u*)(HB + (size_t)tok * D) + 2 * lane; const v4u a = src[0], b = src[1];
            v4u o;
            o.x = pk4_fp8x(bf2f(a.x & 0xffffu), bf2f(a.x >> 16), bf2f(a.y & 0xffffu), bf2f(a.y >> 16)); o.y = pk4_fp8x(bf2f(a.z & 0xffffu), bf2f(a.z >> 16), bf2f(a.w & 0xffffu), bf2f(a.w >> 16));
            o.z = pk4_fp8x(bf2f(b.x & 0xffffu), bf2f(b.x >> 16), bf2f(b.y & 0xffffu), bf2f(b.y >> 16)); o.w = pk4_fp8x(bf2f(b.z & 0xffffu), bf2f(b.z >> 16), bf2f(b.w & 0xffffu), bf2f(b.w >> 16));
            *((v4u*)((unsigned char*)XG + (size_t)slot * D) + lane) = o;
#else
            const v4u* src = (const v4u*)(HB + (size_t)tok * D) + lane; v4u* dst = (v4u*)(XG + (size_t)slot * D) + lane;
            dst[0] = src[0]; dst[64] = src[64];
#endif
        }
        __syncthreads();
    }
    for (int e = 0; e < 8; ++e) {
        const int s0 = seg[e] + tot[e], npad = seg[e + 1] - s0;
        for (int q = bid * nw + wave; q < npad; q += nblk * nw) {
            const int slot = s0 + q;
            if (lane == 0) { TOKI[slot] = -1; GATE[slot] = 0.f; }
            const v4u z = {0u, 0u, 0u, 0u};
#if MOE_FP8
            *((v4u*)((unsigned char*)XG + (size_t)slot * D) + lane) = z;
#else
            v4u* dst = (v4u*)(XG + (size_t)slot * D) + lane; dst[0] = z; dst[64] = z;
#endif
        }
    }
}

__device__ __forceinline__ void ph_combine(const P& p, int last, int bid, int nblk) {
    const int tid = threadIdx.x, nth = blockDim.x, lane = tid & 63, wave = tid >> 6, nw = nth >> 6;
    float* H = (float*)(p.ws + WS_H); bf16* HB = (bf16*)(p.ws + WS_HB); float* SSQ = (float*)(p.ws + WS_SSQ);
    const bf16* Y = (const bf16*)(p.ws + WS_AR + AR_Y);
    const int stride = nblk * nw; int row = bid * nw + wave;
    f32x4 v[4]; v2u ya[4], yb[4];
#if H_BF16
#define CMB_LOAD(r, V, A, B) do { const v2u* hr_ = (const v2u*)(HB + (size_t)(r) * D) + lane; const v2u* y0_ = (const v2u*)(Y + (size_t)(r) * D) + lane; const v2u* y1_ = (const v2u*)(Y + (size_t)(T + (r)) * D) + lane; \
        _Pragma("unroll") for (int j = 0; j < 4; ++j) { const v2u t_ = hr_[64 * j]; V[j].x = bf2f(t_.x & 0xffffu); V[j].y = bf2f(t_.x >> 16); V[j].z = bf2f(t_.y & 0xffffu); V[j].w = bf2f(t_.y >> 16); A[j] = y0_[64 * j]; B[j] = y1_[64 * j]; } } while (0)
#else
#define CMB_LOAD(r, V, A, B) do { const f32x4* hr_ = (const f32x4*)(H + (size_t)(r) * D) + lane; const v2u* y0_ = (const v2u*)(Y + (size_t)(r) * D) + lane; const v2u* y1_ = (const v2u*)(Y + (size_t)(T + (r)) * D) + lane; \
        _Pragma("unroll") for (int j = 0; j < 4; ++j) { V[j] = hr_[64 * j]; A[j] = y0_[64 * j]; B[j] = y1_[64 * j]; } } while (0)
#endif
    if (row < T) CMB_LOAD(row, v, ya, yb);
    for (; row < T; row += stride) {
        f32x4 vn[4]; v2u yan[4], ybn[4];
        { const int rn = row + stride < T ? row + stride : row; CMB_LOAD(rn, vn, yan, ybn); }
        float s = 0.f;
#pragma unroll
        for (int j = 0; j < 4; ++j) {
            const v2u a = ya[j], b = yb[j];
            v[j].x += bf2f(a.x & 0xffffu) + bf2f(b.x & 0xffffu); v[j].y += bf2f(a.x >> 16) + bf2f(b.x >> 16);
            v[j].z += bf2f(a.y & 0xffffu) + bf2f(b.y & 0xffffu); v[j].w += bf2f(a.y >> 16) + bf2f(b.y >> 16);
            s += v[j].x * v[j].x + v[j].y * v[j].y + v[j].z * v[j].z + v[j].w * v[j].w;
        }
        s = wave_sum(s);
        if (last) {
            const float rstd = 1.0f / sqrtf(s * (1.f / D) + EPS);
            f32x4* orow = (f32x4*)(p.out + (size_t)row * D) + lane;
#pragma unroll
            for (int j = 0; j < 4; ++j) { const f32x4 gv = *((const f32x4*)p.fin_g + lane + 64 * j); f32x4 o; o.x = v[j].x * rstd * gv.x; o.y = v[j].y * rstd * gv.y; o.z = v[j].z * rstd * gv.z; o.w = v[j].w * rstd * gv.w; orow[64 * j] = o; }
        } else {
            f32x4* hr = (f32x4*)(H + (size_t)row * D) + lane; v2u* o = (v2u*)(HB + (size_t)row * D) + lane;
#pragma unroll
            for (int j = 0; j < 4; ++j) { if (!H_BF16) hr[64 * j] = v[j]; v2u w; w.x = pk2(v[j].x, v[j].y); w.y = pk2(v[j].z, v[j].w); o[64 * j] = w; }
            if (lane < 16) SSQ[row * 16 + lane] = lane == 0 ? s : 0.f;
        }
#pragma unroll
        for (int j = 0; j < 4; ++j) { v[j] = vn[j]; ya[j] = yan[j]; yb[j] = ybn[j]; }
    }
#undef CMB_LOAD
}


#define GAS __attribute__((address_space(1)))
#define LAS __attribute__((address_space(3)))
typedef short bf16x8 __attribute__((ext_vector_type(8)));
typedef float f32x16 __attribute__((ext_vector_type(16)));
typedef float f32x2 __attribute__((ext_vector_type(2)));
typedef GAS unsigned gu32;
#define RLX_AGENT __ATOMIC_RELAXED, __HIP_MEMORY_SCOPE_AGENT
#define LDS_WAIT() asm volatile("s_waitcnt lgkmcnt(0)" ::: "memory")

constexpr int NWAVES = 8;
constexpr int LDS_BYTES = 147456;
constexpr int LDSCTL_OFF = LDS_BYTES - 512;
constexpr int CW_BAR = 4096;

constexpr size_t WO_IN_E = 0, WO_UQ = 8 * MiB, WO_UKV = 9 * MiB, WO_OUT_E = 10 * MiB, WO_IN_O = 14 * MiB, WO_OUT_O = 26 * MiB, WO_GU_D = 30 * MiB, WO_DN_D = 52 * MiB, WO_GU_M = 63 * MiB, WO_DN_M = 287 * MiB;
enum { WK_IN_E = 0, WK_UQ, WK_UKV, WK_OUT_E, WK_IN_O, WK_OUT_O, WK_GU_D, WK_DN_D, WK_GU_M, WK_DN_M, WK_N };
struct WKind { int K, NS, ND, KD, ninst; size_t off; };
__device__ __host__ constexpr WKind wkind(int k) {
    return k == WK_IN_E ? WKind{1024, 1952, 2048, 1024, 2, WO_IN_E} : k == WK_UQ ? WKind{256, 768, 768, 256, 2, WO_UQ} : k == WK_UKV ? WKind{128, 1024, 1024, 256, 2, WO_UKV}
         : k == WK_OUT_E ? WKind{1024, 1024, 1024, 1024, 2, WO_OUT_E} : k == WK_IN_O ? WKind{1024, 3072, 3072, 1024, 2, WO_IN_O} : k == WK_OUT_O ? WKind{1024, 1024, 1024, 1024, 2, WO_OUT_O}
         : k == WK_GU_D ? WKind{1024, 5632, 5632, 1024, 2, WO_GU_D} : k == WK_DN_D ? WKind{2816, 1024, 1024, 2816, 2, WO_DN_D} : k == WK_GU_M ? WKind{1024, 7168, 7168, 1024, 16, WO_GU_M}
         : WKind{3584, 1024, 1024, 3584, 16, WO_DN_M};
}
__device__ __host__ constexpr long witems(int k) { return (long)wkind(k).ninst * (wkind(k).KD / 64) * (wkind(k).ND / 256); }
__device__ __forceinline__ int srccol(int kind, int n) {
    switch (kind) {
    case WK_IN_E: return n < EIN ? n : -1;
    case WK_UQ: { if (n < 512) return (n >> 6) * 96 + (n & 63); const int t = n - 512, half = t >> 7, tt = t & 127; return (tt >> 4) * 96 + 64 + 16 * half + (tt & 15); }
    case WK_IN_O: { if (n >= 2048) return n; const int pn = n >> 8, t = n & 255, half = t >> 7, tt = t & 127; return (pn < 4 ? 0 : 1024) + 64 * (4 * (pn & 3) + (tt >> 5)) + 32 * half + (tt & 31); }
    case WK_GU_D: { const int pn = n >> 8, t = n & 255; return t < 128 ? 128 * pn + t : FFD + 128 * pn + t - 128; }
    case WK_GU_M: { const int pn = n >> 8, t = n & 255; return t < 128 ? 128 * pn + t : FFE + 128 * pn + t - 128; }
    default: return n;
    }
}
#ifndef MOE_FP8
#define MOE_FP8 1
#endif
struct WItem { const float* W; const float* gain; unsigned char* dst; int K, NS, KD, kind, k0, n0; float wscale; int fp8; };
__device__ __forceinline__ WItem wconv_decode(const P& p, long it) {
    long r = it; int kind = 0;
#pragma unroll
    for (int k = 0; k < WK_N - 1; ++k) { if (kind == k && r >= witems(k)) { r -= witems(k); kind = k + 1; } }
    int K, NS, ND, KD; size_t off; const float* src; const float* gain = nullptr;
    switch (kind) {
#define WCASE(kk) case kk: K = wkind(kk).K; NS = wkind(kk).NS; ND = wkind(kk).ND; KD = wkind(kk).KD; off = wkind(kk).off; break;
        WCASE(WK_IN_E) WCASE(WK_UQ) WCASE(WK_UKV) WCASE(WK_OUT_E) WCASE(WK_IN_O) WCASE(WK_OUT_O) WCASE(WK_GU_D) WCASE(WK_DN_D) WCASE(WK_GU_M) default: WCASE(WK_DN_M)
#undef WCASE
    }
    const int per = (KD / 64) * (ND / 256); const int inst = (int)(r / per), ii = (int)(r % per), nb = ii / (KD / 64), kb = ii % (KD / 64);
    switch (kind) {
    case WK_IN_E: src = p.w_in_e; gain = p.mix_g + (2 * inst) * D; break;
    case WK_UQ: src = p.w_uq; gain = p.qn_g + inst * 256; break;
    case WK_UKV: src = p.w_ukv; gain = p.kvn_g + inst * 128; break;
    case WK_OUT_E: src = p.w_out_e; break;
    case WK_IN_O: src = p.w_in_o; gain = p.mix_g + (2 * inst + 1) * D; break;
    case WK_OUT_O: src = p.w_out_o; break;
    case WK_GU_D: src = p.w_gu_d; gain = p.ffn_g + (2 * inst) * D; break;
    case WK_DN_D: src = p.w_dn_d; break;
    case WK_GU_M: src = p.w_gu_m; gain = p.ffn_g + (2 * (inst >> 3) + 1) * D; break;
    default: src = p.w_dn_m; break;
    }
    WItem w; w.W = src + (size_t)inst * K * NS; w.gain = gain; w.K = K; w.NS = NS; w.KD = KD; w.kind = kind; w.k0 = 64 * kb; w.n0 = 256 * nb;
    const bool f8 = (MOE_FP8 && (kind == WK_GU_M || kind == WK_DN_M)) || (kind == WK_GU_D && ((FFN8_GU >> inst) & 1)) || (kind == WK_DN_D && ((FFN8_DN >> inst) & 1));
    w.fp8 = f8 ? 1 : 0; w.wscale = f8 ? ((kind == WK_GU_M || kind == WK_GU_D) ? 64.f : 128.f) : 1.f;
    w.dst = p.ws + WS_W + off + (size_t)inst * ND * KD * ((kind == WK_GU_M || kind == WK_DN_M) && MOE_FP8 ? 1 : 2);
    return w;
}
constexpr int WC_LD = 257;
__device__ __forceinline__ void wconv_load(const WItem& w, int wave, int lane, f32x4 (&v)[8], float& g, float& ls) {
    const int sc = srccol(w.kind, w.n0 + 4 * lane), scc = sc >= 0 ? sc : 0, kb = w.k0 + 8 * wave;
    ls = sc >= 0 ? w.wscale : 0.f;
    const float* gp = w.gain ? w.gain : w.W;
    { int k = kb + (lane & 7); k = k < w.K ? k : 0; g = gp[k]; }
#pragma unroll
    for (int i = 0; i < 8; ++i) { int k = kb + i; k = k < w.K ? k : 0; v[i] = *(const f32x4*)(w.W + (size_t)k * w.NS + scc); }
}
__device__ __forceinline__ void wconv_lds_write(const WItem& w, int wave, int lane, const f32x4 (&v)[8], float g, float ls, LAS float* tl) {
    const int kb = w.k0 + 8 * wave;
#pragma unroll
    for (int i = 0; i < 8; ++i) {
        const float gi = __int_as_float(__builtin_amdgcn_readlane(__float_as_int(g), i));
        const float s = (kb + i < w.K) ? (w.gain ? ls * gi : ls) : 0.f;
        LAS float* d = tl + (8 * wave + i) * WC_LD + 4 * lane; d[0] = v[i].x * s; d[1] = v[i].y * s; d[2] = v[i].z * s; d[3] = v[i].w * s; }
}
__device__ __forceinline__ void wconv_lds_read_store(const WItem& w, int wave, int lane, LAS float* tl) {
    const int tid = wave * 64 + lane;
    if (w.fp8) {
#pragma unroll
        for (int q = 0; q < 2; ++q) { const int task = tid + 512 * q, n = task >> 2, c = task & 3; const LAS float* s = tl + (16 * c) * WC_LD + n;
            unsigned ww[4];
#pragma unroll
            for (int j = 0; j < 4; ++j) { const LAS float* t = s + (4 * j) * WC_LD; int x = __builtin_amdgcn_cvt_pk_fp8_f32(t[0], t[WC_LD], 0, false); x = __builtin_amdgcn_cvt_pk_fp8_f32(t[2 * WC_LD], t[3 * WC_LD], x, true); ww[j] = (unsigned)x; }
            *(v4u*)(w.dst + (size_t)(w.n0 + n) * w.KD + w.k0 + 16 * c) = (v4u){ww[0], ww[1], ww[2], ww[3]}; }
    } else {
#pragma unroll
        for (int q = 0; q < 4; ++q) { const int task = tid + 512 * q, n = task >> 3, c = task & 7; const LAS float* s = tl + (8 * c) * WC_LD + n;
            v4u o; o.x = pk2(s[0], s[WC_LD]); o.y = pk2(s[2 * WC_LD], s[3 * WC_LD]); o.z = pk2(s[4 * WC_LD], s[5 * WC_LD]); o.w = pk2(s[6 * WC_LD], s[7 * WC_LD]);
            *(v4u*)((bf16*)w.dst + (size_t)(w.n0 + n) * w.KD + w.k0 + 8 * c) = o; }
    }
}
__device__ __forceinline__ void wconv_store(const WItem& w, int wave, int lane, const f32x4 (&v)[8], float g, float ls, LAS float* tl) {
    wconv_lds_write(w, wave, lane, v, g, ls, tl);
    __syncthreads();
    wconv_lds_read_store(w, wave, lane, tl);
    __syncthreads();
}
#ifndef MOE_CONV_OVL
#define MOE_CONV_OVL 1
#endif
constexpr int MOE_CONV_PER_WG = 21, MOE_CONV_BLOCKS = 5376, WCONV_LDS_OFF = 69632;
static_assert(MOE_CONV_BLOCKS == 8 * (16 * 28 + 56 * 4) && MOE_CONV_BLOCKS == 256 * MOE_CONV_PER_WG, "expert weight blocks per odd layer");
__device__ __forceinline__ long witems_before(int kind) { long t = 0;
#pragma unroll
    for (int k = 0; k < WK_N; ++k) if (k < kind) t += witems(k);
    return t; }
__device__ __forceinline__ WItem moe_conv_item(const P& p, int pr, int q) {
    const long it = q < 3584 ? witems_before(WK_GU_M) + (long)pr * 3584 + q : witems_before(WK_DN_M) + (long)pr * 1792 + (q - 3584);
    return wconv_decode(p, it);
}
__device__ __forceinline__ void ph_wconv(const P& p, LAS unsigned char* lds, int bid, int nblk) {
    const int tid = threadIdx.x, lane = tid & 63, wave = __builtin_amdgcn_readfirstlane(tid >> 6);
    LAS float* tl = (LAS float*)lds;
    long total = 0;
#pragma unroll
    for (int k = 0; k < WK_N; ++k) total += witems(k);
    if (nblk == 256 && MOE_FP8 && MOE_CONV_OVL) total = witems_before(WK_GU_M);
    if (bid >= total) return;
    WItem cur = wconv_decode(p, bid); f32x4 v[8]; float g, ls; wconv_load(cur, wave, lane, v, g, ls);
    for (long it = bid; it < total; it += nblk) {
        const bool more = it + nblk < total;
        WItem nxt = cur; f32x4 vn[8]; float gn = 0.f, lsn = 0.f;
        if (more) { nxt = wconv_decode(p, it + nblk); wconv_load(nxt, wave, lane, vn, gn, lsn); }
        wconv_store(cur, wave, lane, v, g, ls, tl);
        if (more) { cur = nxt; g = gn; ls = lsn;
#pragma unroll
            for (int i = 0; i < 8; ++i) v[i] = vn[i]; }
    }
}

namespace pg8 {
typedef int v4i __attribute__((ext_vector_type(4))); typedef int v8i __attribute__((ext_vector_type(8)));
constexpr int BM = 256, BK = 64, HALF = 128, HTB = HALF * BK * 2, NXCD = 8, WGM = 8;
__host__ __device__ __forceinline__ int lds_byte(int r, int c) { const int st = (r >> 4) * 2 + (c >> 5), rr = r & 15, cc = c & 31, ob = rr * 64 + cc * 2; return st * 1024 + (ob ^ (((ob >> 9) & 1) << 5)); }
__host__ __device__ __forceinline__ void stage_rc(int b, int& R, int& C) { const int st = b / 1024, sb = b % 1024, swz = sb ^ (((sb >> 9) & 1) << 5); R = (st >> 1) * 16 + swz / 64; C = (st & 1) * 32 + (swz % 64) / 2; }
__host__ __device__ __forceinline__ int perm32(int rho) { const int n = rho >> 4, i = rho & 15; return 8 * (i >> 2) + 4 * n + (i & 3); }

struct Unit { int pm, pn, e; };
struct Gemm { unsigned char* ws; unsigned aoff, boff; int N, K; };

struct StaticOrder {
    int nM, nN, nwg, G, c, wgm; const int* seg;
    __device__ __forceinline__ void init(int M, int N, int G_, int c_, const int* seg_, int wgm_ = WGM) { asm volatile("" : "+s"(G_), "+s"(c_)); wgm = wgm_;
        seg = seg_; nM = (seg_ ? __builtin_amdgcn_readfirstlane(seg_[8]) : M) / BM; nN = N / BM; nwg = nM * nN; G = G_; c = c_; }
    __device__ __forceinline__ bool next(int i, Unit& u) const {
        const long L = (long)i * G + c; if (L >= nwg) return false;
        int wgid = (int)L; { const int q = nwg / NXCD, r = nwg % NXCD, xcd = wgid % NXCD, off = wgid / NXCD; wgid = (xcd < r ? xcd * (q + 1) : r * (q + 1) + (xcd - r) * q) + off; }
        const int nig = wgm * nN, gid = wgid / nig, fm = gid * wgm, gsz = (nM - fm) < wgm ? (nM - fm) : wgm;
        u.pm = fm + ((wgid % nig) % gsz); u.pn = (wgid % nig) / gsz; u.e = 0;
        if (gid & 1) u.pn = nN - 1 - u.pn;
        if (seg) { int e = 0;
#pragma unroll
            for (int q = 1; q < 8; ++q) e += (seg[q] <= u.pm * BM) ? 1 : 0;
            u.e = __builtin_amdgcn_readfirstlane(e); }
        return true;
    }
};

template <class Epi, class Sched, bool FP8 = false>
__device__ __forceinline__ void gemm_phase(LAS unsigned char* lds, const Gemm g, const Sched& S, const Epi& E) {
    int tid = threadIdx.x; asm volatile("" : "+v"(tid));
    const int wid = __builtin_amdgcn_readfirstlane(tid >> 6), lane = tid & 63, wr = wid >> 2, wc = wid & 3, fr = lane & 15, fq = lane >> 4;
    constexpr unsigned EB = FP8 ? 1u : 2u;
    const int K = g.K, nt = FP8 ? K / 128 : K / BK;
    unsigned voffA, voffB;
    { int R, C; stage_rc(tid * 16, R, C); const int Rb = (R & ~31) + perm32(R & 31);
      voffA = (unsigned)(R * K) * EB + (unsigned)C * 2u; voffB = (unsigned)(Rb * K) * EB + (unsigned)C * 2u; }
    const unsigned r64 = 64u * (unsigned)K * EB;
    const unsigned kstep = (unsigned)(BK * 2);
    const unsigned hstep = (unsigned)HALF * K * EB;
    const unsigned tstep = 2 * hstep;
    unsigned char* wsb = g.ws; asm volatile("" : "+s"(wsb));
    const unsigned ldsw = (unsigned)wid * 1024u;
    const int aoff = lds_byte(wr * 64 + fr, fq * 8), boff = lds_byte(wc * 32 + fr, fq * 8);
#define PG8_SA(b, h) (((b) * 2 + (h)) * HTB)
#define PG8_SB(b, h) ((4 + (b) * 2 + (h)) * HTB)
#define PG8_STAGE(bufoff, goff, voff) do { _Pragma("unroll") for (int _i = 0; _i < 2; ++_i) \
        __builtin_amdgcn_global_load_lds((const unsigned*)(wsb + (unsigned)((goff) + _i * r64 + (voff))), (LAS unsigned*)(lds + (bufoff) + ldsw + _i * 8192), 16, 0, 0); } while (0)
#define PG8_LDA(dst, b, h) do { _Pragma("unroll") for (int m = 0; m < 4; ++m) _Pragma("unroll") for (int k = 0; k < 2; ++k) dst[m][k] = *(const LAS bf16x8*)(lds + PG8_SA(b, h) + aoff + m * 2048 + k * 1024); } while (0)
#define PG8_LDB(dst, b, h) do { _Pragma("unroll") for (int n = 0; n < 2; ++n) _Pragma("unroll") for (int k = 0; k < 2; ++k) dst[n][k] = *(const LAS bf16x8*)(lds + PG8_SB(b, h) + boff + n * 2048 + k * 1024); } while (0)
#define PG8_MMA(ai, bj, At, Bt) do { __builtin_amdgcn_s_setprio(1); _Pragma("unroll") for (int m = 0; m < 4; ++m) _Pragma("unroll") for (int n = 0; n < 2; ++n) { \
        if constexpr (FP8) { const v8i _bb = __builtin_shufflevector(__builtin_bit_cast(v4i, Bt[n][0]), __builtin_bit_cast(v4i, Bt[n][1]), 0, 1, 2, 3, 4, 5, 6, 7), \
                                       _aa = __builtin_shufflevector(__builtin_bit_cast(v4i, At[m][0]), __builtin_bit_cast(v4i, At[m][1]), 0, 1, 2, 3, 4, 5, 6, 7); \
            asm volatile("v_mfma_scale_f32_16x16x128_f8f6f4 %0, %1, %2, %0, %3, %3 op_sel_hi:[0,0,0]" : "+v"(acc[ai][bj][m][n]) : "v"(_bb), "v"(_aa), "v"(0x7f7f7f7f)); }   \
        else { _Pragma("unroll") for (int k = 0; k < 2; ++k) acc[ai][bj][m][n] = __builtin_amdgcn_mfma_f32_16x16x32_bf16(Bt[n][k], At[m][k], acc[ai][bj][m][n], 0, 0, 0); } } \
        __builtin_amdgcn_s_setprio(0); } while (0)
#define PG8_WAIT_V(n) asm volatile("s_waitcnt vmcnt(" #n ")" ::: "memory")
#define PG8_WAIT_L(n) asm volatile("s_waitcnt lgkmcnt(" #n ")" ::: "memory")
#define PG8_BAR __builtin_amdgcn_s_barrier()
#define PG8_SCHED __builtin_amdgcn_sched_barrier(0)
#define PG8_BPTR(u) (g.boff + (unsigned)((u).e * g.N + (u).pn * BM) * (unsigned)K * EB)
    Unit cur, nxt; int ui = 0;
    if (!S.next(0, cur)) return;
    f32x4 acc[2][2][4][2];
#pragma unroll
    for (int a = 0; a < 2; ++a)
#pragma unroll
        for (int b = 0; b < 2; ++b)
#pragma unroll
            for (int m = 0; m < 4; ++m)
#pragma unroll
                for (int n = 0; n < 2; ++n) acc[a][b][m][n] = (f32x4){0.f, 0.f, 0.f, 0.f};
    bf16x8 At[4][2], B0[2][2], B1[2][2];
    unsigned cA = g.aoff + (unsigned)cur.pm * tstep, cB = PG8_BPTR(cur);
    PG8_STAGE(PG8_SB(0, 0), cB, voffB); PG8_STAGE(PG8_SB(0, 1), cB + hstep, voffB); PG8_STAGE(PG8_SA(0, 0), cA, voffA); PG8_STAGE(PG8_SA(0, 1), cA + hstep, voffA);
    if (wr == 1) PG8_BAR;
    PG8_WAIT_V(2); PG8_BAR;
    PG8_STAGE(PG8_SB(1, 0), cB + kstep, voffB); PG8_STAGE(PG8_SA(1, 0), cA + kstep, voffA); PG8_STAGE(PG8_SB(1, 1), cB + hstep + kstep, voffB);
    PG8_WAIT_V(6); PG8_BAR;
    for (;;) {
        const bool has_next = S.next(ui + 1, nxt);
        const unsigned nA = has_next ? g.aoff + (unsigned)nxt.pm * tstep : cA, nB = has_next ? PG8_BPTR(nxt) : cB;
        for (int t = 0; t < nt; t += 2) {
            const bool last = (t == nt - 2);
            const unsigned a1 = cA + (unsigned)(t + 1) * kstep;
            const unsigned a2 = last ? nA : cA + (unsigned)(t + 2) * kstep, b2 = last ? nB : cB + (unsigned)(t + 2) * kstep;
            const unsigned a3 = a2 + kstep, b3 = b2 + kstep;
            PG8_LDB(B0, 0, 0); PG8_LDB(B1, 0, 1); PG8_SCHED; PG8_LDA(At, 0, 0); PG8_STAGE(PG8_SA(1, 1), a1 + hstep, voffA);
            PG8_WAIT_V(8); PG8_WAIT_L(0); PG8_BAR; PG8_MMA(0, 0, At, B0); PG8_MMA(0, 1, At, B1); PG8_BAR; PG8_SCHED;
            PG8_LDA(At, 0, 1); PG8_STAGE(PG8_SB(0, 0), b2, voffB); PG8_STAGE(PG8_SB(0, 1), b2 + hstep, voffB); PG8_STAGE(PG8_SA(0, 0), a2, voffA);
            PG8_WAIT_V(8); PG8_WAIT_L(0); PG8_BAR; PG8_MMA(1, 0, At, B0); PG8_MMA(1, 1, At, B1); PG8_BAR; PG8_SCHED;
            PG8_LDB(B0, 1, 0); PG8_LDB(B1, 1, 1); PG8_SCHED; PG8_LDA(At, 1, 0); PG8_STAGE(PG8_SA(0, 1), a2 + hstep, voffA);
            PG8_WAIT_V(8); PG8_WAIT_L(0); PG8_BAR; PG8_MMA(0, 0, At, B0); PG8_MMA(0, 1, At, B1); PG8_BAR; PG8_SCHED;
            PG8_LDA(At, 1, 1); PG8_STAGE(PG8_SB(1, 0), b3, voffB); PG8_STAGE(PG8_SB(1, 1), b3 + hstep, voffB); PG8_STAGE(PG8_SA(1, 0), a3, voffA);
            PG8_WAIT_V(8); PG8_WAIT_L(0); PG8_BAR; PG8_MMA(1, 0, At, B0); PG8_MMA(1, 1, At, B1); PG8_BAR; PG8_SCHED;
        }
        if (wr == 0) PG8_BAR;
        if constexpr (FP8) { PG8_SCHED; asm volatile("s_nop 15\n\ts_nop 7" ::: "memory"); PG8_SCHED; }
        { int t2 = threadIdx.x; asm volatile("" : "+v"(t2)); const int l2 = t2 & 63;
          E(acc, cur, wr, wc, l2 & 15, l2 >> 4); }
        if (!has_next) break;
#pragma unroll
        for (int a = 0; a < 2; ++a)
#pragma unroll
            for (int b = 0; b < 2; ++b)
#pragma unroll
                for (int m = 0; m < 4; ++m)
#pragma unroll
                    for (int n = 0; n < 2; ++n) acc[a][b][m][n] = (f32x4){0.f, 0.f, 0.f, 0.f};
        cur = nxt; cA = nA; cB = nB; ++ui;
        if (wr == 1) PG8_BAR;
    }
    PG8_WAIT_V(0);
    PG8_BAR;
#undef PG8_SA
#undef PG8_SB
#undef PG8_STAGE
#undef PG8_LDA
#undef PG8_LDB
#undef PG8_MMA
#undef PG8_WAIT_V
#undef PG8_WAIT_L
#undef PG8_BAR
#undef PG8_SCHED
#undef PG8_BPTR
}
}

typedef const f32x4 (&AccRef)[2][2][4][2];
template <class TT> __device__ __forceinline__ TT& wsat(unsigned char* ws, unsigned off) { return *(TT*)(ws + off); }
__device__ __forceinline__ v4u pack8(f32x4 a, f32x4 b, float s) { v4u w; w.x = pk2(a.x * s, a.y * s); w.y = pk2(a.z * s, a.w * s); w.z = pk2(b.x * s, b.y * s); w.w = pk2(b.z * s, b.w * s); return w; }
__device__ __forceinline__ float ssq8(f32x4 a, f32x4 b, float s) { a = a * s; b = b * s; return (a.x * a.x + a.y * a.y) + (a.z * a.z + a.w * a.w) + (b.x * b.x + b.y * b.y) + (b.z * b.z + b.w * b.w); }
__device__ __forceinline__ float fq_sum(float v) { v += __shfl_xor(v, 16); v += __shfl_xor(v, 32); return v; }
constexpr int EPI_LDS_OFF = 131072;
__device__ __forceinline__ void vt_store(unsigned char* ws, LAS unsigned char* lds, int wid, unsigned vt_off, f32x4 a, f32x4 b, float s, int fr, int fq) {
    LAS bf16* scr = (LAS bf16*)(lds + EPI_LDS_OFF + wid * 1024);
    const int p = permk(fr), lane = fq * 16 + fr;
    LAS bf16* w = scr + (8 * fq) * 16 + p;
    w[0 * 16] = (bf16)f2bf(a.x * s); w[1 * 16] = (bf16)f2bf(a.y * s); w[2 * 16] = (bf16)f2bf(a.z * s); w[3 * 16] = (bf16)f2bf(a.w * s);
    w[4 * 16] = (bf16)f2bf(b.x * s); w[5 * 16] = (bf16)f2bf(b.y * s); w[6 * 16] = (bf16)f2bf(b.z * s); w[7 * 16] = (bf16)f2bf(b.w * s);
    asm volatile("s_waitcnt lgkmcnt(0)" ::: "memory");
    const v4u x = *(const LAS v4u*)(scr + (lane >> 1) * 16 + (lane & 1) * 8);
    wsat<v4u>(ws, vt_off + ((unsigned)(lane >> 1) * SEQ + (lane & 1) * 8) * 2u) = x;
    asm volatile("s_waitcnt lgkmcnt(0)" ::: "memory");
}
#define EPI_ROW(ai, m) ((unsigned)(u.pm * 256 + (ai) * 128 + wr * 64 + (m) * 16 + fr))
#define EPI_FOR_AI _Pragma("unroll") for (int ai = 0; ai < 2; ++ai)
#define EPI_FOR_M _Pragma("unroll") for (int m = 0; m < 4; ++m)
constexpr unsigned OA(size_t a) { return (unsigned)(WS_AR + a); }
__device__ __forceinline__ void epi_rstd16(unsigned char* ws, const pg8::Unit& u, int wr, int fr, int fq, float (&rs)[8]) {
    f32x4 part[8];
    EPI_FOR_AI EPI_FOR_M part[ai * 4 + m] = wsat<f32x4>(ws, (unsigned)WS_SSQ + EPI_ROW(ai, m) * 64u + (unsigned)fq * 16u);
#pragma unroll
    for (int i = 0; i < 8; ++i) { const float t = fq_sum((part[i].x + part[i].y) + (part[i].z + part[i].w)); rs[i] = 1.0f / sqrtf(t * (1.f / D) + EPS); }
}
__device__ __forceinline__ void epi_rstd4(unsigned char* ws, unsigned off, float invn, const pg8::Unit& u, int wr, int fr, float (&rs)[8]) {
    f32x4 part[8];
    EPI_FOR_AI EPI_FOR_M part[ai * 4 + m] = wsat<f32x4>(ws, off + EPI_ROW(ai, m) * 16u);
#pragma unroll
    for (int i = 0; i < 8; ++i) rs[i] = 1.0f / sqrtf(((part[i].x + part[i].y) + (part[i].z + part[i].w)) * invn + EPS);
}
__device__ __forceinline__ float clamp448(float v) { return __builtin_amdgcn_fmed3f(v, -448.f, 448.f); }
__device__ __forceinline__ unsigned pk4_fp8(float a, float b, float c, float d) { int w = __builtin_amdgcn_cvt_pk_fp8_f32(clamp448(a), clamp448(b), 0, false); w = __builtin_amdgcn_cvt_pk_fp8_f32(clamp448(c), clamp448(d), w, true); return (unsigned)w; }
constexpr float FP8_WS_GU = 64.f, FP8_WS_DN = 128.f, FP8_AS = 4.f;

__device__ const float RFB[16] = {1.591549431e-01f, 8.949940161e-02f, 5.032921210e-02f, 2.830219583e-02f, 1.591549431e-02f, 8.949940161e-03f, 5.032921210e-03f, 2.830219583e-03f, 1.591549431e-03f, 8.949940161e-04f, 5.032921210e-04f, 2.830219583e-04f, 1.591549431e-04f, 8.949940161e-05f, 5.032921210e-05f, 2.830219583e-05f};
__device__ const float RFC[32] = {1.591549431e-01f, 1.193493702e-01f, 8.949940161e-02f, 6.711508301e-02f, 5.032921210e-02f, 3.774158472e-02f, 2.830219583e-02f, 2.122365276e-02f, 1.591549431e-02f, 1.193493702e-02f, 8.949940161e-03f, 6.711508301e-03f, 5.032921210e-03f, 3.774158472e-03f, 2.830219583e-03f, 2.122365276e-03f, 1.591549431e-03f, 1.193493702e-03f, 8.949940161e-04f, 6.711508301e-04f, 5.032921210e-04f, 3.774158472e-04f, 2.830219583e-04f, 2.122365276e-04f, 1.591549431e-04f, 1.193493702e-04f, 8.949940161e-05f, 6.711508301e-05f, 5.032921210e-05f, 3.774158472e-05f, 2.830219583e-05f, 2.122365276e-05f};
__device__ __forceinline__ void rope_cs8(float posf, const float (&rf)[8], f32x4& c0, f32x4& c1, f32x4& s0, f32x4& s1) {
    float c[8], s[8];
#pragma unroll
    for (int e = 0; e < 8; ++e) { const float r = __builtin_amdgcn_fractf(posf * rf[e]); c[e] = __builtin_amdgcn_cosf(r); s[e] = __builtin_amdgcn_sinf(r); }
    c0 = (f32x4){c[0], c[1], c[2], c[3]}; c1 = (f32x4){c[4], c[5], c[6], c[7]}; s0 = (f32x4){s[0], s[1], s[2], s[3]}; s1 = (f32x4){s[4], s[5], s[6], s[7]};
}
struct EpiEvenIn {
    unsigned char* ws; LAS unsigned char* lds; const int* pos;
    __device__ __forceinline__ void operator()(AccRef acc, const pg8::Unit& u, int wr, int wc, int fr, int fq) const {
        const int pn = u.pn; const unsigned c8 = 32 * wc + 8 * fq;
        float rsv[8]; epi_rstd16(ws, u, wr, fr, fq, rsv);
        int posv[8]; float rf[8];
        if (pn == 7 && wc == 0) { EPI_FOR_AI EPI_FOR_M posv[ai * 4 + m] = pos[EPI_ROW(ai, m)];
#pragma unroll
            for (int e = 0; e < 8; ++e) rf[e] = RFB[8 * (fq & 1) + e]; }
        EPI_FOR_AI {
            EPI_FOR_M { const unsigned row = EPI_ROW(ai, m); const float rs = rsv[ai * 4 + m];
            if (pn < 4) { const unsigned o = (pn < 2 ? OA(AR_QA) : OA(AR_KA)) + (row * 512u + (pn & 1) * 256u + c8) * 2u; const float s = pn < 2 ? rs * (0.125f * LOG2E) : rs;
                wsat<v4u>(ws, o) = pack8(acc[ai][0][m][0], acc[ai][0][m][1], s); wsat<v4u>(ws, o + 256) = pack8(acc[ai][1][m][0], acc[ai][1][m][1], s); }
            else if (pn < 6) { const unsigned r16 = row - fr, b = r16 / SEQ, s16 = r16 % SEQ;
                _Pragma("unroll") for (int bj = 0; bj < 2; ++bj) { const unsigned cc = (pn - 4) * 256 + 128 * bj + 32 * wc, h = cc >> 6, d0 = cc & 63;
                    vt_store(ws, lds, wr * 4 + wc, OA(AR_VAT) + (((b * 8 + h) * 64 + d0) * SEQ + s16) * 2u, acc[ai][bj][m][0], acc[ai][bj][m][1], rs, fr, fq); } }
            else if (pn == 6) { const unsigned o = OA(AR_CQ) + (row * 256u + c8) * 2u;
                wsat<v4u>(ws, o) = pack8(acc[ai][0][m][0], acc[ai][0][m][1], rs); wsat<v4u>(ws, o + 256) = pack8(acc[ai][1][m][0], acc[ai][1][m][1], rs);
                const float ss = fq_sum(ssq8(acc[ai][0][m][0], acc[ai][0][m][1], rs) + ssq8(acc[ai][1][m][0], acc[ai][1][m][1], rs));
                if (fq == 0) wsat<float>(ws, (unsigned)WS_SSQQ + (row * 4u + wc) * 4u) = ss; }
            else { const unsigned o = OA(AR_CKV) + (row * 256u + c8) * 2u;
                wsat<v4u>(ws, o) = pack8(acc[ai][0][m][0], acc[ai][0][m][1], rs); wsat<v4u>(ws, o + 256) = (v4u){0u, 0u, 0u, 0u};
                const float ss = fq_sum(ssq8(acc[ai][0][m][0], acc[ai][0][m][1], rs));
                if (fq == 0) wsat<float>(ws, (unsigned)WS_SSQKV + (row * 4u + wc) * 4u) = ss;
                if (wc == 0) {
                    const f32x4 a = acc[ai][1][m][0] * rs, bq = acc[ai][1][m][1] * rs;
                    float own[8] = {a.x, a.y, a.z, a.w, bq.x, bq.y, bq.z, bq.w}; float o8[8];
                    const unsigned j0 = 8 * (fq & 1);
                    f32x4 c0, c1, s0, s1; rope_cs8((float)posv[ai * 4 + m], rf, c0, c1, s0, s1);
                    const float cs[8] = {c0.x, c0.y, c0.z, c0.w, c1.x, c1.y, c1.z, c1.w}, sn[8] = {s0.x, s0.y, s0.z, s0.w, s1.x, s1.y, s1.z, s1.w};
                    _Pragma("unroll") for (int e = 0; e < 8; ++e) { const float oth = __shfl_xor(own[e], 32); o8[e] = fq < 2 ? own[e] * cs[e] - oth * sn[e] : oth * sn[e] + own[e] * cs[e]; }
                    v4u w; w.x = pk2(o8[0], o8[1]); w.y = pk2(o8[2], o8[3]); w.z = pk2(o8[4], o8[5]); w.w = pk2(o8[6], o8[7]);
                    const unsigned kb = OA(AR_KB) + (row * 768u + 64 + 16 * (fq >> 1) + j0) * 2u;
                    _Pragma("unroll") for (int h = 0; h < 8; ++h) wsat<v4u>(ws, kb + h * 192) = w; } }
            }
        }
    }
};
struct EpiUq {
    unsigned char* ws; const int* pos;
    __device__ __forceinline__ void operator()(AccRef acc, const pg8::Unit& u, int wr, int wc, int fr, int fq) const {
        const int pn = u.pn; const float sc = 0.10206207261596575f * LOG2E;
        float rsv[8]; epi_rstd4(ws, (unsigned)WS_SSQQ, 1.f / 256, u, wr, fr, rsv);
        int posv[8]; float rf[8];
        if (pn == 2) { EPI_FOR_AI EPI_FOR_M posv[ai * 4 + m] = pos[EPI_ROW(ai, m)];
#pragma unroll
            for (int e = 0; e < 8; ++e) rf[e] = RFB[8 * (fq & 1) + e]; }
        EPI_FOR_AI {
            EPI_FOR_M { const unsigned row = EPI_ROW(ai, m); const float rs = rsv[ai * 4 + m] * sc; const unsigned qrow = OA(AR_QB) + row * 1536u;
            if (pn < 2) { _Pragma("unroll") for (int bj = 0; bj < 2; ++bj) { const unsigned h = 4 * pn + 2 * bj + (wc >> 1), d = 32 * (wc & 1) + 8 * fq;
                    wsat<v4u>(ws, qrow + (h * 96 + d) * 2u) = pack8(acc[ai][bj][m][0], acc[ai][bj][m][1], rs); } }
            else { const unsigned head = 2 * wc + (fq >> 1), j0 = 8 * (fq & 1);
                f32x4 c0, c1, s0, s1; rope_cs8((float)posv[ai * 4 + m], rf, c0, c1, s0, s1);
                const f32x4 x10 = acc[ai][0][m][0], x11 = acc[ai][0][m][1], x20 = acc[ai][1][m][0], x21 = acc[ai][1][m][1];
                wsat<v4u>(ws, qrow + (head * 96 + 64 + j0) * 2u) = pack8(x10 * c0 - x20 * s0, x11 * c1 - x21 * s1, rs);
                wsat<v4u>(ws, qrow + (head * 96 + 80 + j0) * 2u) = pack8(x10 * s0 + x20 * c0, x11 * s1 + x21 * c1, rs); }
            }
        }
    }
};
struct EpiUkv {
    unsigned char* ws; LAS unsigned char* lds;
    __device__ __forceinline__ void operator()(AccRef acc, const pg8::Unit& u, int wr, int wc, int fr, int fq) const {
        float rsv[8]; epi_rstd4(ws, (unsigned)WS_SSQKV, 1.f / 128, u, wr, fr, rsv);
        EPI_FOR_AI EPI_FOR_M { const unsigned row = EPI_ROW(ai, m); const float rs = rsv[ai * 4 + m]; const unsigned r16 = row - fr, b = r16 / SEQ, s16 = r16 % SEQ;
            _Pragma("unroll") for (int bj = 0; bj < 2; ++bj) { const unsigned h = 2 * u.pn + bj;
                if (wc < 2) wsat<v4u>(ws, OA(AR_KB) + (row * 768u + h * 96 + 32 * wc + 8 * fq) * 2u) = pack8(acc[ai][bj][m][0], acc[ai][bj][m][1], rs);
                else vt_store(ws, lds, wr * 4 + wc, OA(AR_VBT) + (((b * 8 + h) * 64 + 32 * (wc - 2)) * SEQ + s16) * 2u, acc[ai][bj][m][0], acc[ai][bj][m][1], rs, fr, fq); }
        }
    }
};
template <bool W8, bool WB = true> struct EpiRes {
    unsigned char* ws; const float* res; float oscale;
    __device__ __forceinline__ void operator()(AccRef acc, const pg8::Unit& u, int wr, int wc, int fr, int fq) const {
#if H_BF16
        v4u rv[8][2];
        EPI_FOR_AI EPI_FOR_M _Pragma("unroll") for (int bj = 0; bj < 2; ++bj) rv[ai * 4 + m][bj] = wsat<v4u>(ws, (unsigned)WS_HB + (EPI_ROW(ai, m) * 1024u + u.pn * 256 + 128 * bj + 32 * wc + 8 * fq) * 2u);
        EPI_FOR_AI EPI_FOR_M { const unsigned row = EPI_ROW(ai, m);
            float ss = 0.f;
            _Pragma("unroll") for (int bj = 0; bj < 2; ++bj) { const unsigned e = row * 1024u + u.pn * 256 + 128 * bj + 32 * wc + 8 * fq; const v4u t = rv[ai * 4 + m][bj];
                const f32x4 h0 = (f32x4){bf2f(t.x & 0xffffu), bf2f(t.x >> 16), bf2f(t.y & 0xffffu), bf2f(t.y >> 16)} + acc[ai][bj][m][0] * oscale;
                const f32x4 h1 = (f32x4){bf2f(t.z & 0xffffu), bf2f(t.z >> 16), bf2f(t.w & 0xffffu), bf2f(t.w >> 16)} + acc[ai][bj][m][1] * oscale;
                if (W8) { v2u w8; w8.x = pk4_fp8(h0.x, h0.y, h0.z, h0.w); w8.y = pk4_fp8(h1.x, h1.y, h1.z, h1.w); wsat<v2u>(ws, OA(AR_HB8) + e) = w8; }
                wsat<v4u>(ws, (unsigned)WS_HB + e * 2u) = pack8(h0, h1, 1.f);
                if (WB) ss += ssq8(h0, h1, 1.f); }
            if (WB) { ss = fq_sum(ss);
            if (fq == 0) wsat<float>(ws, (unsigned)WS_SSQ + (row * 16u + 4 * u.pn + wc) * 4u) = ss; }
        }
#else
        EPI_FOR_AI {
            f32x4 rv[4][2][2];
            EPI_FOR_M _Pragma("unroll") for (int bj = 0; bj < 2; ++bj) { const unsigned e = EPI_ROW(ai, m) * 1024u + u.pn * 256 + 128 * bj + 32 * wc + 8 * fq;
                const f32x4* rp = (const f32x4*)((const unsigned char*)res + e * 4u); rv[m][bj][0] = rp[0]; rv[m][bj][1] = rp[1]; }
            EPI_FOR_M { const unsigned row = EPI_ROW(ai, m);
            float ss = 0.f;
            _Pragma("unroll") for (int bj = 0; bj < 2; ++bj) { const unsigned e = row * 1024u + u.pn * 256 + 128 * bj + 32 * wc + 8 * fq;
                const f32x4 h0 = rv[m][bj][0] + acc[ai][bj][m][0] * oscale, h1 = rv[m][bj][1] + acc[ai][bj][m][1] * oscale;
                if (W8) { v2u w8; w8.x = pk4_fp8(h0.x, h0.y, h0.z, h0.w); w8.y = pk4_fp8(h1.x, h1.y, h1.z, h1.w); wsat<v2u>(ws, OA(AR_HB8) + e) = w8; }
                wsat<f32x4>(ws, (unsigned)WS_H + e * 4u) = h0; wsat<f32x4>(ws, (unsigned)WS_H + e * 4u + 16) = h1;
                if (WB) { wsat<v4u>(ws, (unsigned)WS_HB + e * 2u) = pack8(h0, h1, 1.f); ss += ssq8(h0, h1, 1.f); } }
            if (WB) { ss = fq_sum(ss);
            if (fq == 0) wsat<float>(ws, (unsigned)WS_SSQ + (row * 16u + 4 * u.pn + wc) * 4u) = ss; }
            }
        }
#endif
    }
};
struct EpiOddIn {
    unsigned char* ws; LAS unsigned char* lds; const int* pos;
    __device__ __forceinline__ void operator()(AccRef acc, const pg8::Unit& u, int wr, int wc, int fr, int fq) const {
        const int pn = u.pn;
        float rsv[8]; epi_rstd16(ws, u, wr, fr, fq, rsv);
        int posv[8]; float rf[8];
        if (pn < 8) { EPI_FOR_AI EPI_FOR_M posv[ai * 4 + m] = pos[EPI_ROW(ai, m)];
#pragma unroll
            for (int e = 0; e < 8; ++e) rf[e] = RFC[8 * fq + e]; }
        EPI_FOR_AI {
            EPI_FOR_M { const unsigned row = EPI_ROW(ai, m); const float rs = rsv[ai * 4 + m];
            if (pn < 8) { const unsigned mm = 4 * (pn & 3) + wc, j0 = 8 * fq; const float s = pn < 4 ? rs * (0.125f * LOG2E) : rs;
                f32x4 c0, c1, s0, s1; rope_cs8((float)posv[ai * 4 + m], rf, c0, c1, s0, s1);
                const f32x4 x10 = acc[ai][0][m][0], x11 = acc[ai][0][m][1], x20 = acc[ai][1][m][0], x21 = acc[ai][1][m][1];
                const unsigned o = (pn < 4 ? OA(AR_QC) : OA(AR_KC)) + (row * 1024u + (mm >> 1) * 128 + (mm & 1) * 64 + j0) * 2u;
                wsat<v4u>(ws, o) = pack8(x10 * c0 - x20 * s0, x11 * c1 - x21 * s1, s);
                wsat<v4u>(ws, o + 64) = pack8(x10 * s0 + x20 * c0, x11 * s1 + x21 * c1, s); }
            else { const unsigned r16 = row - fr, b = r16 / SEQ, s16 = r16 % SEQ;
                _Pragma("unroll") for (int bj = 0; bj < 2; ++bj) { const unsigned h = 2 * (pn - 8) + bj;
                    vt_store(ws, lds, wr * 4 + wc, OA(AR_VCT) + (((b * 8 + h) * 128 + 32 * wc) * SEQ + s16) * 2u, acc[ai][bj][m][0], acc[ai][bj][m][1], rs, fr, fq); } }
            }
        }
    }
};
__device__ __forceinline__ float silu_mul(float g2, float u2) { return g2 * u2 * __builtin_amdgcn_rcpf(1.f + __builtin_amdgcn_exp2f(-g2)); }
template <bool NORM> struct EpiSwigluFp8 {
    unsigned char* ws; unsigned aoff; int ldc;
    __device__ __forceinline__ void operator()(AccRef acc, const pg8::Unit& u, int wr, int wc, int fr, int fq) const {
        float rsv[8];
        if (NORM) epi_rstd16(ws, u, wr, fr, fq, rsv);
        EPI_FOR_AI EPI_FOR_M { const unsigned row = EPI_ROW(ai, m);
            const float rs = (NORM ? rsv[ai * 4 + m] : 1.f) * (1.f / FP8_WS_GU);
            const f32x4 g0 = acc[ai][0][m][0] * (rs * LOG2E), g1 = acc[ai][0][m][1] * (rs * LOG2E), u0 = acc[ai][1][m][0] * (rs * (FP8_AS / LOG2E)), u1 = acc[ai][1][m][1] * (rs * (FP8_AS / LOG2E));
            v2u w; w.x = pk4_fp8(silu_mul(g0.x, u0.x), silu_mul(g0.y, u0.y), silu_mul(g0.z, u0.z), silu_mul(g0.w, u0.w));
            w.y = pk4_fp8(silu_mul(g1.x, u1.x), silu_mul(g1.y, u1.y), silu_mul(g1.z, u1.z), silu_mul(g1.w, u1.w));
            wsat<v2u>(ws, aoff + row * (unsigned)ldc + 128 * u.pn + 32 * wc + 8 * fq) = w;
        }
    }
};
template <bool NORM> struct EpiSwiglu {
    unsigned char* ws; unsigned aoff; int ldc;
    __device__ __forceinline__ void operator()(AccRef acc, const pg8::Unit& u, int wr, int wc, int fr, int fq) const {
        float rsv[8];
        if (NORM) epi_rstd16(ws, u, wr, fr, fq, rsv);
        EPI_FOR_AI EPI_FOR_M { const unsigned row = EPI_ROW(ai, m);
            const float rs = NORM ? rsv[ai * 4 + m] : 1.f;
            const f32x4 g0 = acc[ai][0][m][0] * (rs * LOG2E), g1 = acc[ai][0][m][1] * (rs * LOG2E), u0 = acc[ai][1][m][0] * (rs * (1.f / LOG2E)), u1 = acc[ai][1][m][1] * (rs * (1.f / LOG2E));
            v4u w; w.x = pk2(silu_mul(g0.x, u0.x), silu_mul(g0.y, u0.y)); w.y = pk2(silu_mul(g0.z, u0.z), silu_mul(g0.w, u0.w));
            w.z = pk2(silu_mul(g1.x, u1.x), silu_mul(g1.y, u1.y)); w.w = pk2(silu_mul(g1.z, u1.z), silu_mul(g1.w, u1.w));
            wsat<v4u>(ws, aoff + (row * (unsigned)ldc + 128 * u.pn + 32 * wc + 8 * fq) * 2u) = w;
        }
    }
};
template <bool NORM, bool W8, bool A8> struct EpiSwigluX {
    unsigned char* ws; unsigned aoff; int ldc;
    __device__ __forceinline__ void operator()(AccRef acc, const pg8::Unit& u, int wr, int wc, int fr, int fq) const {
        float rsv[8];
        if (NORM) epi_rstd16(ws, u, wr, fr, fq, rsv);
        EPI_FOR_AI EPI_FOR_M { const unsigned row = EPI_ROW(ai, m);
            const float rs = (NORM ? rsv[ai * 4 + m] : 1.f) * (W8 ? 1.f / FP8_WS_GU : 1.f), us = rs * (A8 ? FP8_AS : 1.f) * (1.f / LOG2E);
            const f32x4 g0 = acc[ai][0][m][0] * (rs * LOG2E), g1 = acc[ai][0][m][1] * (rs * LOG2E), u0 = acc[ai][1][m][0] * us, u1 = acc[ai][1][m][1] * us;
            if (A8) { v2u w; w.x = pk4_fp8(silu_mul(g0.x, u0.x), silu_mul(g0.y, u0.y), silu_mul(g0.z, u0.z), silu_mul(g0.w, u0.w));
                w.y = pk4_fp8(silu_mul(g1.x, u1.x), silu_mul(g1.y, u1.y), silu_mul(g1.z, u1.z), silu_mul(g1.w, u1.w));
                wsat<v2u>(ws, aoff + row * (unsigned)ldc + 128 * u.pn + 32 * wc + 8 * fq) = w; }
            else { v4u w; w.x = pk2(silu_mul(g0.x, u0.x), silu_mul(g0.y, u0.y)); w.y = pk2(silu_mul(g0.z, u0.z), silu_mul(g0.w, u0.w));
                w.z = pk2(silu_mul(g1.x, u1.x), silu_mul(g1.y, u1.y)); w.w = pk2(silu_mul(g1.z, u1.z), silu_mul(g1.w, u1.w));
                wsat<v4u>(ws, aoff + (row * (unsigned)ldc + 128 * u.pn + 32 * wc + 8 * fq) * 2u) = w; }
        }
    }
};
struct EpiMoeDown {
    unsigned char* ws; float oscale;
    __device__ __forceinline__ void operator()(AccRef acc, const pg8::Unit& u, int wr, int wc, int fr, int fq) const {
        int tiv[8]; float gtv[8];
        EPI_FOR_AI EPI_FOR_M { const unsigned row = EPI_ROW(ai, m); tiv[ai * 4 + m] = wsat<int>(ws, (unsigned)WS_TOKI + row * 4u); gtv[ai * 4 + m] = wsat<float>(ws, (unsigned)WS_GATE + row * 4u); }
        EPI_FOR_AI EPI_FOR_M { const int ti = tiv[ai * 4 + m];
            if (ti >= 0) { const float gt = gtv[ai * 4 + m] * oscale; const unsigned o = OA(AR_Y) + (((unsigned)(ti & 1) * T + (unsigned)(ti >> 1)) * 1024u + u.pn * 256 + 32 * wc + 8 * fq) * 2u;
                wsat<v4u>(ws, o) = pack8(acc[ai][0][m][0], acc[ai][0][m][1], gt); wsat<v4u>(ws, o + 256) = pack8(acc[ai][1][m][0], acc[ai][1][m][1], gt); }
        }
    }
};

__device__ __forceinline__ float xhalf_max(float m) { auto rr = __builtin_amdgcn_permlane32_swap(__float_as_uint(m), __float_as_uint(m), false, false); return fmaxf(__uint_as_float(rr[0]), __uint_as_float(rr[1])); }
__device__ __forceinline__ float xhalf_sum(float m) { auto rr = __builtin_amdgcn_permlane32_swap(__float_as_uint(m), __float_as_uint(m), false, false); return __uint_as_float(rr[0]) + __uint_as_float(rr[1]); }
__device__ __forceinline__ float max3f(float a, float b, float c) { float r; asm("v_max3_f32 %0, %1, %2, %3" : "=v"(r) : "v"(a), "v"(b), "v"(c)); return r; }
__device__ __forceinline__ int crow(int r, int hi) { return (r & 3) + 8 * (r >> 2) + 4 * hi; }
constexpr int ATT_TAB_OFF = 57344;

struct CvState { int done, step, next; };
#ifndef MOE_CONV_PERIOD
#define MOE_CONV_PERIOD 7
#endif
template <int MODE>
__device__ __forceinline__ void attn_unit(const P& p, LAS unsigned char* lds, int layer, int b, int h, int qb, float lam_init, float lam, CvState& cs, int cvid) {
    constexpr int DK = MODE == 0 ? 64 : (MODE == 1 ? 96 : 128), DQK = MODE == 1 ? 96 : 64, DV = MODE == 2 ? 128 : 64;
    constexpr int PITCH = MODE == 0 ? 512 : (MODE == 1 ? 768 : 1024), HD = MODE == 0 ? 64 : (MODE == 1 ? 96 : 128);
    constexpr int KROW = DK * 2 + 16, VROW = 144, KST = 64 * KROW, VST = DV * VROW, STAGE = KST + VST;
    constexpr int NKP = 64 * DK / 8, KPT = (NKP + 511) / 512, NVP = DV * 8, VPT = NVP / 512, NS = DQK / 16, NDV = DV / 32, CPR = DK / 8;
    static_assert(3 * STAGE <= (MODE == 0 ? ATT_TAB_OFF : LDSCTL_OFF) && 65536 <= LDSCTL_OFF, "attention LDS map");
    int tid = threadIdx.x; asm volatile("" : "+v"(tid));
    const int lane = tid & 63, w = __builtin_amdgcn_readfirstlane(tid >> 6), l31 = lane & 31, hi = lane >> 5;
    const int i2 = layer >> 1;
    unsigned char* ar = p.ws + WS_AR;
    const bf16* Q = (const bf16*)(ar + (MODE == 0 ? AR_QA : MODE == 1 ? AR_QB : AR_QC));
    const bf16* Kp = (const bf16*)(ar + (MODE == 0 ? AR_KA : MODE == 1 ? AR_KB : AR_KC));
    const bf16* VT = (const bf16*)(ar + (MODE == 0 ? AR_VAT : MODE == 1 ? AR_VBT : AR_VCT));
    bf16* O = (bf16*)(ar + AR_MIX);
    const int wq = MODE == 2 ? (w & 3) : w, kd0 = MODE == 2 ? (w >> 2) * 64 : 0;
    const int c0 = MODE == 2 ? qb * 2 : qb * 4, cq = c0 + (wq >> 1);
    const int qrow0 = c0 * 64 + 32 * wq;
    const int jhi_u = c0 + (MODE == 2 ? 1 : 3), jlo_u = MODE == 0 ? (c0 > 8 ? c0 - 8 : 0) : 0;
    const int jlo_w = MODE == 0 ? (cq > 8 ? cq - 8 : 0) : 0, jhi_w = cq;
    const bf16* Kg = Kp + (size_t)b * SEQ * PITCH + h * HD;
    const bf16* Vg = VT + (size_t)(b * 8 + h) * DV * SEQ;
    bf16x8 qf[NS];
    { const bf16* qp = Q + (size_t)(b * SEQ + qrow0 + l31) * PITCH + h * HD + kd0 + 8 * hi;
#pragma unroll
      for (int s = 0; s < NS; ++s) qf[s] = *(const bf16x8*)(qp + 16 * s); }
    if (MODE == 0) { LAS float* tab = (LAS float*)(lds + ATT_TAB_OFF); const float* rb = p.relb + ((size_t)i2 * 8 + h) * 513; for (int i = tid; i < 513; i += 512) tab[i] = rb[i] * LOG2E; }
    constexpr bool KFULL = (NKP % 512) == 0;
    int kgo[KPT], klo[KPT], vgo[VPT], vlo[VPT]; bool kok[KPT];
#pragma unroll
    for (int i = 0; i < KPT; ++i) { const int pc = tid + 512 * i; kok[i] = pc < NKP; const int key = pc / CPR, ch = pc % CPR; kgo[i] = key * PITCH + ch * 8; klo[i] = key * KROW + ch * 16; }
#pragma unroll
    for (int i = 0; i < VPT; ++i) { const int pc = tid + 512 * i, dv = pc >> 3, ch = pc & 7; vgo[i] = dv * SEQ + ch * 8; vlo[i] = KST + dv * VROW + ch * 16; }
    v4u kreg[KPT], vreg[VPT];
#define ATT_LOAD(j) do { _Pragma("unroll") for (int i = 0; i < KPT; ++i) if (KFULL || kok[i]) kreg[i] = *(const v4u*)(Kg + (size_t)(j) * 64 * PITCH + kgo[i]); \
        _Pragma("unroll") for (int i = 0; i < VPT; ++i) vreg[i] = *(const v4u*)(Vg + (j) * 64 + vgo[i]); } while (0)
#define ATT_WRITE(so) do { _Pragma("unroll") for (int i = 0; i < KPT; ++i) if (KFULL || kok[i]) *(LAS v4u*)(lds + (so) + klo[i]) = kreg[i]; \
        _Pragma("unroll") for (int i = 0; i < VPT; ++i) *(LAS v4u*)(lds + (so) + vlo[i]) = vreg[i]; } while (0)
    f32x16 o[NDV];
#pragma unroll
    for (int d = 0; d < NDV; ++d) o[d] = f32x16{};
    constexpr float ATT_THR = 8.f;
    float mrun = 0.f, lrun = 0.f; f32x16 negm = f32x16{};
    ATT_LOAD(jlo_u); ATT_WRITE(0);
    if (jlo_u < jhi_u) ATT_LOAD(jlo_u + 1);
    __syncthreads();
    int sb = 0;
    WItem cw; f32x4 cv[8]; float cg = 0.f, cls = 0.f; int cst = 0, cage = 0; cw.fp8 = 0;
    LAS float* ctl = (LAS float*)(lds + WCONV_LDS_OFF);
    static_assert(MODE == 2 || 3 * STAGE <= WCONV_LDS_OFF, "conversion tile above the K/V stages");
    for (int j = jlo_u; j <= jhi_u; ++j) {
        const int sb1 = (sb == 2 * STAGE) ? 0 : sb + STAGE;
        if (MODE != 2 && cvid >= 0) {
            if (cst == 2) { wconv_lds_read_store(cw, w, lane, ctl); cst = 0; }
            else if (cst == 1 && ++cage >= 2) { wconv_lds_write(cw, w, lane, cv, cg, cls, ctl); cst = 2; }
        }
        if (j < jhi_u) ATT_WRITE(sb1);
        if (j + 1 < jhi_u) ATT_LOAD(j + 2);
        if (MODE != 2 && cvid >= 0) {
            if (cst == 0 && cs.done < MOE_CONV_PER_WG && jhi_u - j >= 3 && cs.step >= cs.next) {
                cw = moe_conv_item(p, layer >> 1, cvid + 256 * cs.done); wconv_load(cw, w, lane, cv, cg, cls); cst = 1; cage = 0; ++cs.done; cs.next = cs.step + MOE_CONV_PERIOD; }
            ++cs.step; }
        if (j >= jlo_w && j <= jhi_w) {
            const LAS unsigned char* Kl = lds + sb; const LAS unsigned char* Vl = Kl + KST;
            f32x16 sa[2];
            { bf16x8 kf[2 * NS];
#pragma unroll
              for (int kh = 0; kh < 2; ++kh)
#pragma unroll
                for (int s = 0; s < NS; ++s) kf[kh * NS + s] = *(const LAS bf16x8*)(Kl + (32 * kh + l31) * KROW + (kd0 + 16 * s + 8 * hi) * 2);
#pragma unroll
              for (int kh = 0; kh < 2; ++kh)
#pragma unroll
                for (int s = 0; s < NS; ++s) sa[kh] = __builtin_amdgcn_mfma_f32_32x32x16_bf16(kf[kh * NS + s], qf[s], s == 0 ? negm : sa[kh], 0, 0, 0); }
            asm volatile("s_nop 15\n\ts_nop 7" : "+v"(sa[0]), "+v"(sa[1]));
            bf16x8 vf[8];
#pragma unroll
            for (int d = 0; d < 2; ++d)
#pragma unroll
                for (int ks = 0; ks < 4; ++ks) vf[d * 4 + ks] = *(const LAS bf16x8*)(Vl + (32 * d + l31) * VROW + (16 * ks + 8 * hi) * 2);
            if (MODE == 0) { const LAS float* tab = (const LAS float*)(lds + ATT_TAB_OFF); const int dc = cq - j;
                if (dc >= 5) { const float bv = tab[512];
#pragma unroll
                    for (int r = 0; r < 16; ++r) { sa[0][r] += bv; sa[1][r] += bv; } }
                else { const int rel0 = 64 * dc + 32 * (wq & 1) + l31 + 256;
#pragma unroll
                    for (int kh = 0; kh < 2; ++kh)
#pragma unroll
                        for (int r = 0; r < 16; ++r) { int idx = rel0 - (32 * kh + crow(r, hi)); idx = idx > 512 ? 512 : idx; sa[kh][r] += tab[idx]; } } }
            float mx = max3f(sa[0][0], sa[1][0], sa[0][1]), my = max3f(sa[1][1], sa[0][2], sa[1][2]);
#pragma unroll
            for (int r = 3; r < 15; r += 2) { mx = max3f(mx, sa[0][r], sa[1][r]); my = max3f(my, sa[0][r + 1], sa[1][r + 1]); }
            mx = max3f(mx, sa[0][15], sa[1][15]); mx = max3f(mx, my, my);
            mx = xhalf_max(mx);
            const bool first = (j == jlo_w);
            if (first || __any(mx > ATT_THR)) {
                const float dl = first ? mx : fmaxf(mx, 0.f);
                mrun += dl;
#pragma unroll
                for (int r = 0; r < 16; ++r) { sa[0][r] -= dl; sa[1][r] -= dl; negm[r] = -mrun; }
                if (!first) { const float alpha = __builtin_amdgcn_exp2f(-dl); lrun *= alpha;
#pragma unroll
                    for (int d = 0; d < NDV; ++d)
#pragma unroll
                        for (int r = 0; r < 16; ++r) o[d][r] *= alpha; }
            }
            float ls = 0.f;
#pragma unroll
            for (int kh = 0; kh < 2; ++kh)
#pragma unroll
                for (int r = 0; r < 16; ++r) { const float e = __builtin_amdgcn_exp2f(sa[kh][r]); sa[kh][r] = e; ls += e; }
            lrun += ls;
            bf16x8 pb[4];
#pragma unroll
            for (int ks = 0; ks < 4; ++ks) { const int kh = ks >> 1, r0 = 8 * (ks & 1); v4u t;
                t.x = pk2(sa[kh][r0 + 0], sa[kh][r0 + 1]); t.y = pk2(sa[kh][r0 + 2], sa[kh][r0 + 3]); t.z = pk2(sa[kh][r0 + 4], sa[kh][r0 + 5]); t.w = pk2(sa[kh][r0 + 6], sa[kh][r0 + 7]);
                pb[ks] = __builtin_bit_cast(bf16x8, t); }
            if (NDV == 4) { bf16x8 vg[8];
#pragma unroll
                for (int d = 0; d < 2; ++d)
#pragma unroll
                    for (int ks = 0; ks < 4; ++ks) vg[d * 4 + ks] = *(const LAS bf16x8*)(Vl + (32 * (d + 2) + l31) * VROW + (16 * ks + 8 * hi) * 2);
#pragma unroll
                for (int d = 0; d < 2; ++d)
#pragma unroll
                    for (int ks = 0; ks < 4; ++ks) o[d] = __builtin_amdgcn_mfma_f32_32x32x16_bf16(vf[d * 4 + ks], pb[ks], o[d], 0, 0, 0);
#pragma unroll
                for (int d = 0; d < 2; ++d)
#pragma unroll
                    for (int ks = 0; ks < 4; ++ks) o[NDV - 2 + d] = __builtin_amdgcn_mfma_f32_32x32x16_bf16(vg[d * 4 + ks], pb[ks], o[NDV - 2 + d], 0, 0, 0);
            } else {
#pragma unroll
                for (int d = 0; d < 2; ++d)
#pragma unroll
                    for (int ks = 0; ks < 4; ++ks) o[d] = __builtin_amdgcn_mfma_f32_32x32x16_bf16(vf[d * 4 + ks], pb[ks], o[d], 0, 0, 0);
            }
        }
        sb = sb1;
        __syncthreads();
    }
#undef ATT_LOAD
#undef ATT_WRITE
    const float linv = 1.f / xhalf_sum(lrun);
    const size_t tok = (size_t)b * SEQ + qrow0 + l31;
    if (MODE != 2) {
        bf16* orow = O + tok * 1024 + (MODE == 1 ? 512 : 0) + h * 64 + 8 * hi;
#pragma unroll
        for (int d = 0; d < NDV; ++d)
#pragma unroll
            for (int g = 0; g < 4; g += 2) {
                unsigned ax = pk2(o[d][4 * g] * linv, o[d][4 * g + 1] * linv), ay = pk2(o[d][4 * g + 2] * linv, o[d][4 * g + 3] * linv);
                unsigned bx = pk2(o[d][4 * g + 4] * linv, o[d][4 * g + 5] * linv), by = pk2(o[d][4 * g + 6] * linv, o[d][4 * g + 7] * linv);
                { auto r = __builtin_amdgcn_permlane32_swap(ax, bx, false, false); ax = r[0]; bx = r[1]; }
                { auto r = __builtin_amdgcn_permlane32_swap(ay, by, false, false); ay = r[0]; by = r[1]; }
                *(v4u*)(orow + 32 * d + 8 * g) = (v4u){ax, ay, bx, by}; }
    } else {
        LAS float* xch = (LAS float*)lds + (size_t)(w & 3) * 4096 + lane;
        if (w >= 4) {
#pragma unroll
            for (int d = 0; d < NDV; ++d)
#pragma unroll
                for (int r = 0; r < 16; ++r) xch[(d * 16 + r) * 64] = o[d][r] * linv;
        }
        __syncthreads();
        if (w < 4) {
            const float* sg = p.subln + i2 * 128 + 4 * hi; f32x4 gvv[NDV][4];
#pragma unroll
            for (int d = 0; d < NDV; ++d)
#pragma unroll
                for (int g = 0; g < 4; ++g) gvv[d][g] = *(const f32x4*)(sg + 32 * d + 8 * g);
            float ss = 0.f;
#pragma unroll
            for (int d = 0; d < NDV; ++d)
#pragma unroll
                for (int r = 0; r < 16; ++r) { const float v = o[d][r] * linv - lam * xch[(d * 16 + r) * 64]; o[d][r] = v; ss += v * v; }
            ss = xhalf_sum(ss);
            const float rs = (1.f - lam_init) / sqrtf(ss * (1.f / 128) + EPS);
            bf16* orow = O + tok * 1024 + h * 128 + 8 * hi;
#pragma unroll
            for (int d = 0; d < NDV; ++d)
#pragma unroll
                for (int g = 0; g < 4; g += 2) { const f32x4 ga = gvv[d][g], gb = gvv[d][g + 1];
                    unsigned ax = pk2(o[d][4 * g] * rs * ga.x, o[d][4 * g + 1] * rs * ga.y), ay = pk2(o[d][4 * g + 2] * rs * ga.z, o[d][4 * g + 3] * rs * ga.w);
                    unsigned bx = pk2(o[d][4 * g + 4] * rs * gb.x, o[d][4 * g + 5] * rs * gb.y), by = pk2(o[d][4 * g + 6] * rs * gb.z, o[d][4 * g + 7] * rs * gb.w);
                    { auto r = __builtin_amdgcn_permlane32_swap(ax, bx, false, false); ax = r[0]; bx = r[1]; }
                    { auto r = __builtin_amdgcn_permlane32_swap(ay, by, false, false); ay = r[0]; by = r[1]; }
                    *(v4u*)(orow + 32 * d + 8 * g) = (v4u){ax, ay, bx, by}; }
        }
        __syncthreads();
    }
}

template <int MODE>
__device__ __forceinline__ void attn_phase(const P& p, LAS unsigned char* lds, int layer, int vcu, int G, float lam_init, CvState& cs) {
    constexpr int NQB = MODE == 2 ? 32 : 16, NU = 64 * NQB;
    float lam = 0.f;
    if (MODE == 2) { const int lane = threadIdx.x & 63, i2 = layer >> 1;
        const float a1 = wave_sum(p.lq1[i2 * 64 + lane] * p.lk1[i2 * 64 + lane]), a2 = wave_sum(p.lq2[i2 * 64 + lane] * p.lk2[i2 * 64 + lane]);
        lam = expf(a1) - expf(a2) + lam_init; }
    const bool bal = (G == 256);
    const int nit = bal ? NQB / 4 : (NU - vcu + G - 1) / G;
#pragma unroll 1
    for (int i = 0; i < nit; ++i) {
        int bh, qb;
        if (bal) { const int s = vcu & 3; bh = vcu >> 2; qb = 4 * i + ((i & 1) ? 3 - s : s); } else { const int u = vcu + i * G; bh = u / NQB; qb = u % NQB; }
        attn_unit<MODE>(p, lds, layer, bh >> 3, bh & 7, qb, lam_init, lam, cs, (MODE != 2 && bal && MOE_FP8 && MOE_CONV_OVL) ? vcu : -1);
    }
}


__device__ __forceinline__ void moe_conv_rest(const P& p, LAS unsigned char* lds, int pr, int vcu, int G, CvState& cs) {
    if (G != 256 || !MOE_FP8 || !MOE_CONV_OVL) return;
    const int tid = threadIdx.x, lane = tid & 63, wave = __builtin_amdgcn_readfirstlane(tid >> 6);
    LAS float* tl = (LAS float*)(lds + WCONV_LDS_OFF);
    for (; cs.done < MOE_CONV_PER_WG; ++cs.done) { const WItem w = moe_conv_item(p, pr, vcu + 256 * cs.done); f32x4 v[8]; float g, ls; wconv_load(w, wave, lane, v, g, ls); wconv_store(w, wave, lane, v, g, ls, tl); }
}

#define XB_TMO      128
#define XB_XCNT(j)  (256  + 64 * (j))
#define XB_XSUB(j)  (1280 + 64 * (j))
#define XB_XGEN(j)  (2304 + 64 * (j))
#define XB_TOP      3328
#define XB_TOPGEN   3392
#define XCD_BAR_WORDS 3456
#define XB_SPIN_CAP (1u << 18)

__device__ __forceinline__ unsigned xb_ld(unsigned* p)              { return __hip_atomic_load(p, __ATOMIC_RELAXED, __HIP_MEMORY_SCOPE_AGENT); }
__device__ __forceinline__ unsigned xb_add(unsigned* p, unsigned v) { return __hip_atomic_fetch_add(p, v, __ATOMIC_RELAXED, __HIP_MEMORY_SCOPE_AGENT); }
__device__ __forceinline__ unsigned xb_xcc_id() { return (unsigned)__builtin_amdgcn_s_getreg((3 << 11) | 20) & 0xFu; }
#define XB_SPIN(cond, bar) do { unsigned _sp = 0; while (cond) { __builtin_amdgcn_s_sleep(1); \
    if ((++_sp & 255u) == 0u) { if (xb_ld(&(bar)[XB_TMO])) break; if (_sp > XB_SPIN_CAP) { atomicAdd(&(bar)[XB_TMO], 1u); break; } } } } while (0)

struct XcdBarrier {
    unsigned* bar; unsigned x;
    volatile LAS unsigned* st;
};

__device__ __forceinline__ XcdBarrier xcd_barrier_post(unsigned* bar, volatile LAS unsigned* st) {
    XcdBarrier b; b.bar = bar; b.x = xb_xcc_id(); b.st = st;
    if (threadIdx.x == 0) (void)xb_add(&bar[XB_XCNT(b.x)], 1u);
    return b;
}
__device__ __forceinline__ void xcd_barrier_complete(unsigned* bar, unsigned x, unsigned& nloc, unsigned& nx) {
    const unsigned G = gridDim.x * gridDim.y * gridDim.z;
    unsigned sum, cnt, mine, sp = 0u;
    for (;;) {
        sum = 0u; cnt = 0u; mine = 0u;
#pragma unroll
        for (unsigned j = 0; j < 16; ++j) { const unsigned c = xb_ld(&bar[XB_XCNT(j)]); sum += c; cnt += (c > 0u) ? 1u : 0u; mine = (j == x) ? c : mine; }
        if (sum == G) break;
        __builtin_amdgcn_s_sleep(1);
        if ((++sp & 255u) == 0u) { if (xb_ld(&bar[XB_TMO])) break; if (sp > XB_SPIN_CAP) { atomicAdd(&bar[XB_TMO], 1u); break; } }
    }
    nloc = mine > 0u ? mine : 1u; nx = cnt > 0u ? cnt : 1u;
}

__device__ __forceinline__ void xcd_barrier(const XcdBarrier& b) {
    asm volatile("s_waitcnt vmcnt(0)" ::: "memory");
    __syncthreads();
    if (threadIdx.x == 0) {
        unsigned* bar = b.bar;
        __builtin_amdgcn_s_waitcnt(0);
        unsigned nloc = b.st[0], nx = b.st[1];
        if (nloc == 0u) { xcd_barrier_complete(bar, b.x, nloc, nx); b.st[0] = nloc; b.st[1] = nx; }
        const unsigned old = xb_add(&bar[XB_XSUB(b.x)], 1u);
        const unsigned gen = old / nloc;
        if (old + 1u == (gen + 1u) * nloc) {
            __builtin_amdgcn_fence(__ATOMIC_RELEASE, "agent");
            asm volatile("s_waitcnt vmcnt(0)" ::: "memory");
            const unsigned og = xb_add(&bar[XB_TOP], 1u);
            const unsigned tg = og / nx;
            if (og + 1u == (tg + 1u) * nx) xb_add(&bar[XB_TOPGEN], 1u);
            else XB_SPIN(xb_ld(&bar[XB_TOPGEN]) == tg, bar);
            __builtin_amdgcn_fence(__ATOMIC_ACQUIRE, "agent");
            xb_add(&bar[XB_XGEN(b.x)], 1u);
            asm volatile("s_waitcnt vmcnt(0)" ::: "memory");
        } else {
            XB_SPIN(xb_ld(&bar[XB_XGEN(b.x)]) == gen, bar);
            __builtin_amdgcn_fence(__ATOMIC_ACQUIRE, "agent");
            asm volatile("s_waitcnt vmcnt(0)" ::: "memory");
        }
    }
    __syncthreads();
}


constexpr int NPHASE = 29;
struct Args { P p; int ph_lo, ph_hi; };
#define CAS __attribute__((address_space(4)))
#if defined(__HIP_DEVICE_COMPILE__)
__device__ __forceinline__ const CAS Args* kargs() { const CAS Args* q = (const CAS Args*)__builtin_amdgcn_kernarg_segment_ptr(); asm volatile("" : "+s"(q)); return q; }
#else
__device__ const Args* kargs();
#endif
#ifndef PHASE_MASK
#define PHASE_MASK 0x7fff
#endif
#define PHEN(t) (((PHASE_MASK) >> (t)) & 1)
#define IN(k) (lo <= (k) && (k) < hi)
#define SEAM(k) do { if (IN(k) && IN((k) + 1)) xcd_barrier(bar); } while (0)
#define PH_ENV const P p = kargs()->p; unsigned char* ws = p.ws; unsigned char* ar = ws + WS_AR; unsigned char* wb = ws + WS_W; \
    const bf16* HB = (const bf16*)(ws + WS_HB); float* H = (float*)(ws + WS_H); float* SSQ = (float*)(ws + WS_SSQ); \
    const int* SEG = (const int*)(ws + WS_META); (void)ar; (void)wb; (void)HB; (void)H; (void)SSQ; (void)SEG;
#ifndef WGM_BF16
#define WGM_BF16 4
#endif
template <int pr>
__device__ __forceinline__ void layer_pair(LAS unsigned char* lds, const int lo, const int hi, const XcdBarrier& bar, const int bid, const int G, const int vcu) {
        const int base = 1 + 14 * pr, le = 2 * pr, lod = 2 * pr + 1;
        if (PHEN(0) && IN(base + 0)) { PH_ENV
            pg8::Gemm g{ws, (unsigned)WS_HB, (unsigned)(WS_W + WO_IN_E) + (unsigned)pr * 2048u * 1024u * 2u, 2048, 1024}; pg8::StaticOrder S; S.init(T, 2048, G, bid, nullptr, WGM_BF16);
            EpiEvenIn E{ws, lds, p.pos};
            pg8::gemm_phase(lds, g, S, E); SEAM(base + 0);
        }
        if (PHEN(1) && IN(base + 1)) { PH_ENV
            { pg8::Gemm g{ws, OA(AR_CQ), (unsigned)(WS_W + WO_UQ) + (unsigned)pr * 768u * 256u * 2u, 768, 256}; pg8::StaticOrder S; S.init(T, 768, G, bid, nullptr);
              EpiUq E{ws, p.pos}; pg8::gemm_phase(lds, g, S, E); }
            { pg8::Gemm g{ws, OA(AR_CKV), (unsigned)(WS_W + WO_UKV) + (unsigned)pr * 1024u * 256u * 2u, 1024, 256}; pg8::StaticOrder S; S.init(T, 1024, G, bid, nullptr);
              EpiUkv E{ws, lds}; pg8::gemm_phase(lds, g, S, E); }
            SEAM(base + 1);
        }
        if (PHEN(2) && IN(base + 2)) { PH_ENV CvState cs{0, 0, vcu % MOE_CONV_PERIOD}; attn_phase<0>(p, lds, le, vcu, G, 0.f, cs); attn_phase<1>(p, lds, le, vcu, G, 0.f, cs); moe_conv_rest(p, lds, pr, vcu, G, cs); SEAM(base + 2); }
        if (PHEN(3) && IN(base + 3)) { PH_ENV
            pg8::Gemm g{ws, OA(AR_MIX), (unsigned)(WS_W + WO_OUT_E) + (unsigned)pr * 1024u * 1024u * 2u, 1024, 1024}; pg8::StaticOrder S; S.init(T, 1024, G, bid, nullptr);
            EpiRes<((FFN8_GU >> pr) & 1) != 0> E{ws, pr == 0 ? p.x : (const float*)H, 1.f}; pg8::gemm_phase(lds, g, S, E); SEAM(base + 3);
        }
        if (PHEN(4) && IN(base + 4)) { PH_ENV
            constexpr bool A8 = ((FFN8_DN >> pr) & 1) != 0;
            if constexpr (((FFN8_GU >> pr) & 1) != 0) {
                pg8::Gemm g{ws, OA(AR_HB8), (unsigned)(WS_W + WO_GU_D) + (unsigned)pr * 5632u * 1024u * 2u, 5632, 1024}; pg8::StaticOrder S; S.init(T, 5632, G, bid, nullptr);
                EpiSwigluX<true, true, A8> E{ws, OA(AR_ACT), FFD}; pg8::gemm_phase<EpiSwigluX<true, true, A8>, pg8::StaticOrder, true>(lds, g, S, E);
            } else {
                pg8::Gemm g{ws, (unsigned)WS_HB, (unsigned)(WS_W + WO_GU_D) + (unsigned)pr * 5632u * 1024u * 2u, 5632, 1024}; pg8::StaticOrder S; S.init(T, 5632, G, bid, nullptr, WGM_BF16);
                EpiSwigluX<true, false, A8> E{ws, OA(AR_ACT), FFD}; pg8::gemm_phase(lds, g, S, E);
            }
            SEAM(base + 4);
        }
        if (PHEN(5) && IN(base + 5)) { PH_ENV
            if constexpr (((FFN8_DN >> pr) & 1) != 0) {
                pg8::Gemm g{ws, OA(AR_ACT), (unsigned)(WS_W + WO_DN_D) + (unsigned)pr * 1024u * 2816u * 2u, 1024, 2816}; pg8::StaticOrder S; S.init(T, 1024, G, bid, nullptr);
                EpiRes<false> E{ws, (const float*)H, 1.f / (FP8_AS * FP8_WS_DN)}; pg8::gemm_phase<EpiRes<false>, pg8::StaticOrder, true>(lds, g, S, E);
            } else {
                pg8::Gemm g{ws, OA(AR_ACT), (unsigned)(WS_W + WO_DN_D) + (unsigned)pr * 1024u * 2816u * 2u, 1024, 2816}; pg8::StaticOrder S; S.init(T, 1024, G, bid, nullptr);
                EpiRes<false> E{ws, (const float*)H, 1.f}; pg8::gemm_phase(lds, g, S, E);
            }
            SEAM(base + 5);
        }
        if (PHEN(6) && IN(base + 6)) { PH_ENV
            pg8::Gemm g{ws, (unsigned)WS_HB, (unsigned)(WS_W + WO_IN_O) + (unsigned)pr * 3072u * 1024u * 2u, 3072, 1024}; pg8::StaticOrder S; S.init(T, 3072, G, bid, nullptr, WGM_BF16);
            EpiOddIn E{ws, lds, p.pos}; pg8::gemm_phase(lds, g, S, E); SEAM(base + 6);
        }
        if (PHEN(7) && IN(base + 7)) { PH_ENV CvState cs{0, 0, 0}; attn_phase<2>(p, lds, lod, vcu, G, pr == 0 ? 0.35550906759096934f : 0.5560582041556406f, cs); SEAM(base + 7); }
        if (PHEN(8) && IN(base + 8)) { PH_ENV
            pg8::Gemm g{ws, OA(AR_MIX), (unsigned)(WS_W + WO_OUT_O) + (unsigned)pr * 1024u * 1024u * 2u, 1024, 1024}; pg8::StaticOrder S; S.init(T, 1024, G, bid, nullptr);
            EpiRes<false, false> E{ws, (const float*)H, 1.f}; pg8::gemm_phase(lds, g, S, E); SEAM(base + 8);
        }
        if (PHEN(9) && IN(base + 9)) { PH_ENV ph_route(p, lod, bid, G, (LAS int*)lds); SEAM(base + 9); }
        if (PHEN(10) && IN(base + 10)) { PH_ENV ph_gather(p, bid, G, (LAS int*)lds); SEAM(base + 10); }
        if (PHEN(11) && IN(base + 11)) { PH_ENV
#if MOE_FP8
            pg8::Gemm g{ws, OA(AR_XG), (unsigned)(WS_W + WO_GU_M) + (unsigned)pr * 8u * 7168u * 1024u, 7168, 1024}; pg8::StaticOrder S; S.init(0, 7168, G, bid, SEG);
            EpiSwigluFp8<false> E{ws, OA(AR_ACTM), FFE}; pg8::gemm_phase<EpiSwigluFp8<false>, pg8::StaticOrder, true>(lds, g, S, E); SEAM(base + 11);
#else
            pg8::Gemm g{ws, OA(AR_XG), (unsigned)(WS_W + WO_GU_M) + (unsigned)pr * 8u * 7168u * 1024u * 2u, 7168, 1024}; pg8::StaticOrder S; S.init(0, 7168, G, bid, SEG);
            EpiSwiglu<false> E{ws, OA(AR_ACTM), FFE}; pg8::gemm_phase(lds, g, S, E); SEAM(base + 11);
#endif
        }
        if (PHEN(12) && IN(base + 12)) { PH_ENV
#if MOE_FP8
            pg8::Gemm g{ws, OA(AR_ACTM), (unsigned)(WS_W + WO_DN_M) + (unsigned)pr * 8u * 1024u * 3584u, 1024, 3584}; pg8::StaticOrder S; S.init(0, 1024, G, bid, SEG);
            EpiMoeDown E{ws, 1.f / (FP8_AS * FP8_WS_DN)}; pg8::gemm_phase<EpiMoeDown, pg8::StaticOrder, true>(lds, g, S, E); SEAM(base + 12);
#else
            pg8::Gemm g{ws, OA(AR_ACTM), (unsigned)(WS_W + WO_DN_M) + (unsigned)pr * 8u * 1024u * 3584u * 2u, 1024, 3584}; pg8::StaticOrder S; S.init(0, 1024, G, bid, SEG);
            EpiMoeDown E{ws, 1.f}; pg8::gemm_phase(lds, g, S, E); SEAM(base + 12);
#endif
        }
        if (PHEN(13) && IN(base + 13)) { PH_ENV ph_combine(p, pr == 1, bid, G); SEAM(base + 13); }
}
__global__ void __launch_bounds__(NWAVES * 64, 2) mega(Args args) {
    extern __shared__ __attribute__((aligned(16))) unsigned char lds_raw[];
    LAS unsigned char* lds = (LAS unsigned char*)lds_raw;
    const int tid = threadIdx.x, G = gridDim.x, bid = blockIdx.x;
    const int vcu = (G % 8 == 0) ? (bid % 8) * (G / 8) + bid / 8 : bid;
    volatile LAS unsigned* MISC = (volatile LAS unsigned*)(lds + LDSCTL_OFF);
    for (int u = tid; u < 128; u += NWAVES * 64) MISC[u] = 0u;
    __syncthreads();
    const int lo = kargs()->ph_lo, hi = kargs()->ph_hi;
    unsigned* const barw = (unsigned*)(kargs()->p.ws + WS_CTL) + CW_BAR;
    XcdBarrier bar; bar.bar = barw; bar.x = 0; bar.st = nullptr;
    if (hi - lo > 1) bar = xcd_barrier_post(barw, MISC + 8);

    if (PHEN(14) && IN(0)) { PH_ENV ph_wconv(p, lds, bid, G); ph_prologue(p, bid, G); SEAM(0); }
    layer_pair<0>(lds, lo, hi, bar, bid, G, vcu);
    layer_pair<1>(lds, lo, hi, bar, bid, G, vcu);
#undef IN
#undef SEAM
#undef PH_ENV
}


extern "C" void kernel_launch(void* const* d_in, const int* in_sizes, int n_in, void* d_out, int out_size, void* d_ws, size_t ws_size, hipStream_t stream) {
    static int grid = 0;
    if (grid == 0) {
        if (n_in != 24 || ws_size < WS_TMP) fprintf(stderr, "kernel_launch: unexpected n_in %d or ws_size %zu (need %zu)\n", n_in, ws_size, (size_t)WS_TMP);
        int dev = 0, cus = 0, per_cu = 0;
        if (hipGetDevice(&dev) != hipSuccess || hipDeviceGetAttribute(&cus, hipDeviceAttributeMultiprocessorCount, dev) != hipSuccess) { fprintf(stderr, "kernel_launch: device query failed\n"); grid = -1; return; }
        if (hipFuncSetAttribute((const void*)mega, hipFuncAttributeMaxDynamicSharedMemorySize, LDS_BYTES) != hipSuccess) { fprintf(stderr, "kernel_launch: hipFuncSetAttribute failed\n"); grid = -1; return; }
        if (hipOccupancyMaxActiveBlocksPerMultiprocessor(&per_cu, (const void*)mega, NWAVES * 64, LDS_BYTES) != hipSuccess || per_cu < 1) fprintf(stderr, "kernel_launch: occupancy query reports %d blocks per CU\n", per_cu);
        (void)hipGetLastError();
        grid = cus;
    }
    if (grid < 0) return;
    Args a{};
    P& p = a.p;
    p.x = (const float*)d_in[0]; p.pos = (const int*)d_in[1]; p.mix_g = (const float*)d_in[2]; p.ffn_g = (const float*)d_in[3]; p.w_in_e = (const float*)d_in[4]; p.relb = (const float*)d_in[5];
    p.qn_g = (const float*)d_in[6]; p.w_uq = (const float*)d_in[7]; p.kvn_g = (const float*)d_in[8]; p.w_ukv = (const float*)d_in[9]; p.w_out_e = (const float*)d_in[10]; p.w_in_o = (const float*)d_in[11];
    p.lq1 = (const float*)d_in[12]; p.lk1 = (const float*)d_in[13]; p.lq2 = (const float*)d_in[14]; p.lk2 = (const float*)d_in[15]; p.subln = (const float*)d_in[16]; p.w_out_o = (const float*)d_in[17];
    p.w_gu_d = (const float*)d_in[18]; p.w_dn_d = (const float*)d_in[19]; p.w_rt = (const float*)d_in[20]; p.w_gu_m = (const float*)d_in[21]; p.w_dn_m = (const float*)d_in[22]; p.fin_g = (const float*)d_in[23];
    p.out = (float*)d_out; p.ws = (unsigned char*)d_ws;
    (void)hipMemsetAsync((unsigned char*)d_ws + WS_CTL, 0, 65536, stream);
#if ONE_LAUNCH
    a.ph_lo = 0; a.ph_hi = NPHASE;
    hipLaunchKernelGGL(mega, dim3(grid), dim3(NWAVES * 64), LDS_BYTES, stream, a);
#else
    for (int k = 0; k < NPHASE; ++k) {
        a.ph_lo = k; a.ph_hi = k + 1;
        hipLaunchKernelGGL(mega, dim3(grid), dim3(NWAVES * 64), LDS_BYTES, stream, a);
#if defined(DUP_MASK)
        if ((DUP_MASK >> (k == 0 ? 14 : (k - 1) % 14)) & 1) for (int r = 0; r < DUP_N; ++r) hipLaunchKernelGGL(mega, dim3(grid), dim3(NWAVES * 64), LDS_BYTES, stream, a);
#endif
    }
#endif
    const hipError_t le = hipPeekAtLastError();
    if (le != hipSuccess) fprintf(stderr, "kernel_launch: launch failed: %s\n", hipGetErrorName(le));
}
```
